# Optimizing an MI355X kernel written in HIP

```python
import math
import jax, jax.numpy as jnp
from jax import lax
import numpy as np

D_MODEL = 1024
BATCH = 16
SEQ = 4096
DEPTH = 1
DEC_BATCH = 1
DEC_SEQ = 16384
PAST_LEN = 128

ATT_HEADS = 16
ATT_KV_HEADS = 4
ATT_HEAD_DIM = 64
ATT_GROUP = ATT_HEADS // ATT_KV_HEADS
WINDOW = 128
ATT_BLOCK = 128
ROT_DIM = ATT_HEAD_DIM // 4
ROPE_THETA = 500000.0
NEG_BIG = -1e30
HG_HEADS = 8
HG_DK = 128
HG_DV = 128
HG_CHUNK = 64
D_FF = 2816
LN_EPS = 1e-5
RMS_EPS = 1e-6
DN_ALPHA = (2.0 * DEPTH) ** 0.25
DN_BETA = (8.0 * DEPTH) ** -0.25
COL_WIDTHS = (ATT_HEADS * ATT_HEAD_DIM, ATT_KV_HEADS * ATT_HEAD_DIM, ATT_KV_HEADS * ATT_HEAD_DIM,
              HG_HEADS * HG_DK, HG_HEADS * HG_DK, HG_HEADS * HG_DK,
              HG_HEADS * HG_DV, HG_HEADS * HG_DV, D_MODEL, D_MODEL)
SPLIT_POINTS = tuple(int(s) for s in np.cumsum(COL_WIDTHS)[:-1])
D_IN_PROJ = int(sum(COL_WIDTHS))

kernel_name = "hybrid_gated_swa_hgrn2_macaron_deepnorm"


def _layer_norm(x, g, b):
    xf = x.astype(jnp.float32)
    mu = jnp.mean(xf, axis=-1, keepdims=True)
    var = jnp.mean(jnp.square(xf - mu), axis=-1, keepdims=True)
    return ((xf - mu) * lax.rsqrt(var + LN_EPS)).astype(x.dtype) * g + b


def _swiglu(x, w_in, w_out):
    gate, up = jnp.split(x @ w_in, 2, axis=-1)
    return (jax.nn.silu(gate) * up) @ w_out


def _rope_partial(x, pos):
    half = ROT_DIM // 2
    inv = ROPE_THETA ** (-jnp.arange(half, dtype=jnp.float32) / half)
    ang = pos.astype(jnp.float32)[:, None] * inv[None, :]
    cos = jnp.cos(ang)[None, :, None, :].astype(x.dtype)
    sin = jnp.sin(ang)[None, :, None, :].astype(x.dtype)
    x1 = x[..., :half]
    x2 = x[..., half:ROT_DIM]
    return jnp.concatenate([x1 * cos - x2 * sin, x2 * cos + x1 * sin, x[..., ROT_DIM:]], axis=-1)


def _window_attention(q, k, v, sink):
    B, L = q.shape[0], q.shape[1]
    nb = L // ATT_BLOCK
    qb = q.reshape(B, nb, ATT_BLOCK, ATT_KV_HEADS, ATT_GROUP, ATT_HEAD_DIM)
    pad = ((0, 0), (ATT_BLOCK, ATT_BLOCK), (0, 0), (0, 0))
    kb = jnp.pad(k, pad).reshape(B, nb + 2, ATT_BLOCK, ATT_KV_HEADS, ATT_HEAD_DIM)
    vb = jnp.pad(v, pad).reshape(B, nb + 2, ATT_BLOCK, ATT_KV_HEADS, ATT_HEAD_DIM)
    kw = jnp.concatenate([kb[:, :-2], kb[:, 1:-1], kb[:, 2:]], axis=2)
    vw = jnp.concatenate([vb[:, :-2], vb[:, 1:-1], vb[:, 2:]], axis=2)
    qi = jnp.arange(ATT_BLOCK)[:, None]
    kj = jnp.arange(3 * ATT_BLOCK)[None, :] - ATT_BLOCK
    band = jnp.abs(kj - qi) <= WINDOW
    sink_l = sink.astype(jnp.float32).reshape(ATT_KV_HEADS, ATT_GROUP)[None, :, :, None, None]
    scale = ATT_HEAD_DIM ** -0.5

    def one_block(args):
        qn, kn, vn, n = args
        kpos = n * ATT_BLOCK + kj
        valid = band & (kpos >= 0) & (kpos < L)
        s = jnp.einsum('bqkgd,bskd->bkgqs', qn, kn).astype(jnp.float32) * scale
        s = jnp.where(valid, s, NEG_BIG)
        m = jnp.maximum(jnp.max(s, axis=-1, keepdims=True), sink_l)
        e = jnp.exp(s - m)
        p = e / (jnp.sum(e, axis=-1, keepdims=True) + jnp.exp(sink_l - m))
        return jnp.einsum('bkgqs,bskd->bqkgd', p.astype(vn.dtype), vn)

    out = lax.map(one_block, (jnp.swapaxes(qb, 0, 1), jnp.swapaxes(kw, 0, 1),
                              jnp.swapaxes(vw, 0, 1), jnp.arange(nb)))
    return jnp.swapaxes(out, 0, 1).reshape(B, L, ATT_HEADS * ATT_HEAD_DIM)


def _hgrn2_chunk_scan(q, k, v, logf):
    B, H, L, dk = q.shape
    dv = v.shape[-1]
    nc = L // HG_CHUNK
    q = q.reshape(B, H, nc, HG_CHUNK, dk)
    k = k.reshape(B, H, nc, HG_CHUNK, dk)
    v = v.reshape(B, H, nc, HG_CHUNK, dv)
    b = jnp.cumsum(logf.reshape(B, H, nc, HG_CHUNK, dk), axis=3)
    b_last = b[:, :, :, -1:, :]
    q_dec = q * jnp.exp(b)
    k_inv = k * jnp.exp(-b)
    k_end = k * jnp.exp(b_last - b)
    incl = jnp.tril(jnp.ones((HG_CHUNK, HG_CHUNK), dtype=bool))
    a = jnp.where(incl, jnp.einsum('bhnid,bhnjd->bhnij', q_dec, k_inv), 0.0)
    o_intra = jnp.einsum('bhnij,bhnje->bhnie', a, v)
    s_chunk = jnp.einsum('bhncd,bhnce->bhnde', k_end, v)
    decay = jnp.exp(b_last[:, :, :, 0, :])

    def step(s, inp):
        dec, sc = inp
        return dec[..., None] * s + sc, s

    s0 = jnp.zeros((B, H, dk, dv), jnp.float32)
    _, s_prev = lax.scan(step, s0, (jnp.moveaxis(decay, 2, 0), jnp.moveaxis(s_chunk, 2, 0)))
    s_prev = jnp.moveaxis(s_prev, 0, 2)
    o_inter = jnp.einsum('bhncd,bhnde->bhnce', q_dec, s_prev)
    return (o_intra + o_inter).reshape(B, H, L, dv)


def _hgrn2_branch(hq, hf_fwd, hf_bwd, hi, hg, lb_fwd, lb_bwd, norm_g):
    B, L = hq.shape[0], hq.shape[1]

    def heads(t):
        return t.astype(jnp.float32).reshape(B, L, HG_HEADS, -1).transpose(0, 2, 1, 3)

    q = heads(jax.nn.silu(hq))
    v = heads(hi)

    def direction(fz, lb, reverse):
        f = heads(lb + (1.0 - lb) * jax.nn.sigmoid(fz.astype(jnp.float32)))
        qq, kk, vv, lf = q, 1.0 - f, v, jnp.log(f)
        if reverse:
            qq, kk, vv, lf = (jnp.flip(t, axis=2) for t in (qq, kk, vv, lf))
        o = _hgrn2_chunk_scan(qq, kk, vv, lf)
        return jnp.flip(o, axis=2) if reverse else o

    o = direction(hf_fwd, lb_fwd, False) + direction(hf_bwd, lb_bwd, True)
    o = o * lax.rsqrt(jnp.mean(o * o, axis=-1, keepdims=True) + RMS_EPS) * norm_g.astype(jnp.float32)
    o = o.transpose(0, 2, 1, 3).reshape(B, L, HG_HEADS * HG_DV)
    return (o * jax.nn.silu(hg.astype(jnp.float32))).astype(hq.dtype)


def _mixer(x, w_in, sink, lb_fwd, lb_bwd, norm_g, w_o_attn, w_o_hgrn, w_out):
    B, L, _ = x.shape
    aq, ak, av, hq, hff, hfb, hi, hg, ga, gh = jnp.split(x @ w_in, SPLIT_POINTS, axis=-1)
    pos = jnp.arange(L)
    aq = _rope_partial(aq.reshape(B, L, ATT_HEADS, ATT_HEAD_DIM), pos)
    ak = _rope_partial(ak.reshape(B, L, ATT_KV_HEADS, ATT_HEAD_DIM), pos)
    av = av.reshape(B, L, ATT_KV_HEADS, ATT_HEAD_DIM)
    attn = _window_attention(aq, ak, av, sink) @ w_o_attn
    hgrn = _hgrn2_branch(hq, hff, hfb, hi, hg, lb_fwd, lb_bwd, norm_g) @ w_o_hgrn
    merged = jax.nn.sigmoid(ga) * attn + jax.nn.sigmoid(gh) * hgrn
    return merged @ w_out


def setup_inputs(seed: int = 0) -> dict:
    key = jax.random.key(seed)
    ks = jax.random.split(key, 20)
    f32 = jnp.float32
    nrm = lambda k, shape, s: jax.random.normal(k, shape, f32) * s
    return {
        "x_prompt": nrm(ks[0], (BATCH, SEQ, D_MODEL), 1.0),
        "x_sample": nrm(ks[1], (DEC_BATCH, DEC_SEQ, D_MODEL), 1.0),
        "ffn1_w_in": nrm(ks[2], (DEPTH, D_MODEL, 2 * D_FF), D_MODEL ** -0.5),
        "ffn1_w_out": nrm(ks[3], (DEPTH, D_FF, D_MODEL), DN_BETA * D_FF ** -0.5),
        "ln1_g": 1.0 + nrm(ks[4], (DEPTH, D_MODEL), 0.05),
        "ln1_b": nrm(ks[5], (DEPTH, D_MODEL), 0.02),
        "w_in": nrm(ks[6], (DEPTH, D_MODEL, D_IN_PROJ), D_MODEL ** -0.5),
        "attn_sink": nrm(ks[7], (DEPTH, ATT_HEADS), 0.5),
        "hgrn_lb": 1.0 + nrm(ks[8], (2, DEPTH + 1, HG_HEADS * HG_DK), 0.1),
        "hgrn_norm_g": 1.0 + nrm(ks[9], (DEPTH, HG_DV), 0.05),
        "w_o_attn": nrm(ks[10], (DEPTH, ATT_HEADS * ATT_HEAD_DIM, D_MODEL), (ATT_HEADS * ATT_HEAD_DIM) ** -0.5),
        "w_o_hgrn": nrm(ks[11], (DEPTH, HG_HEADS * HG_DV, D_MODEL), (HG_HEADS * HG_DV) ** -0.5),
        "w_out": nrm(ks[12], (DEPTH, D_MODEL, D_MODEL), DN_BETA * D_MODEL ** -0.5),
        "ln2_g": 1.0 + nrm(ks[13], (DEPTH, D_MODEL), 0.05),
        "ln2_b": nrm(ks[14], (DEPTH, D_MODEL), 0.02),
        "ffn2_w_in": nrm(ks[15], (DEPTH, D_MODEL, 2 * D_FF), D_MODEL ** -0.5),
        "ffn2_w_out": nrm(ks[16], (DEPTH, D_FF, D_MODEL), DN_BETA * D_FF ** -0.5),
        "ln3_g": 1.0 + nrm(ks[17], (DEPTH, D_MODEL), 0.05),
        "ln3_b": nrm(ks[18], (DEPTH, D_MODEL), 0.02),
    }


def reference(x_prompt, x_sample, ffn1_w_in, ffn1_w_out, ln1_g, ln1_b, w_in, attn_sink, hgrn_lb,
              hgrn_norm_g, w_o_attn, w_o_hgrn, w_out, ln2_g, ln2_b, ffn2_w_in, ffn2_w_out, ln3_g, ln3_b):
    lb_sched = jnp.cumsum(jax.nn.softmax(hgrn_lb.astype(jnp.float32), axis=1), axis=1)

    def trunk(x):
        for l in range(DEPTH):
            lb_f = lb_sched[0, l].astype(x.dtype)
            lb_b = lb_sched[1, l].astype(x.dtype)
            x = _layer_norm(DN_ALPHA * x + 0.5 * _swiglu(x, ffn1_w_in[l], ffn1_w_out[l]), ln1_g[l], ln1_b[l])
            mix = _mixer(x, w_in[l], attn_sink[l], lb_f, lb_b, hgrn_norm_g[l], w_o_attn[l], w_o_hgrn[l], w_out[l])
            x = _layer_norm(DN_ALPHA * x + mix, ln2_g[l], ln2_b[l])
            x = _layer_norm(DN_ALPHA * x + 0.5 * _swiglu(x, ffn2_w_in[l], ffn2_w_out[l]), ln3_g[l], ln3_b[l])
        return x

    y_prompt = trunk(x_prompt)
    y_sample = trunk(x_sample)
    return (y_prompt, y_sample)
```

```cpp
#include <hip/hip_runtime.h>
#include <hip/hip_cooperative_groups.h>
#include <cstdio>
#include <cstdint>
namespace cg = cooperative_groups;
namespace pg8 {
#define PG8_LAS __attribute__((address_space(3)))
typedef unsigned short bf16_t;
typedef short bf16x8 __attribute__((ext_vector_type(8)));
typedef float f32x4 __attribute__((ext_vector_type(4)));
typedef unsigned u32x4 __attribute__((ext_vector_type(4)));
constexpr int BM = 256, BK = 64, HALF = 128, HTB = HALF * BK * 2  , STAGE_BYTES = 8 * HTB, NXCD = 8, WGM = 8;

__host__ __device__ __forceinline__ int lds_byte(int r, int c) { const int st = (r >> 4) * 2 + (c >> 5), rr = r & 15, cc = c & 31, ob = rr * 64 + cc * 2; return st * 1024 + (ob ^ (((ob >> 9) & 1) << 5)); }
__host__ __device__ __forceinline__ void stage_rc(int b, int& R, int& C) { const int st = b / 1024, sb = b % 1024, swz = sb ^ (((sb >> 9) & 1) << 5); R = (st >> 1) * 16 + swz / 64; C = (st & 1) * 32 + (swz % 64) / 2; }
__host__ __device__ __forceinline__ int perm32(int rho) { const int n = rho >> 4, i = rho & 15; return 8 * (i >> 2) + 4 * n + (i & 3); }

struct Unit { int pm, pn; };
struct Gemm { const bf16_t* A; const bf16_t* Bt; int M, N, K; };

struct StaticOrder {
    int nM, nN, nwg, G, c;
    __host__ __device__ void init(int M, int N, int G_, int c_) { nM = M / BM; nN = N / BM; nwg = nM * nN; G = G_; c = c_; }
    __host__ __device__ bool next(int i, Unit& u) const {
        const long L = (long)i * G + c; if (L >= nwg) return false;
        int wgid = (int)L; { const int q = nwg / NXCD, r = nwg % NXCD, xcd = wgid % NXCD, off = wgid / NXCD; wgid = (xcd < r ? xcd * (q + 1) : r * (q + 1) + (xcd - r) * q) + off; }
        const int nig = WGM * nN, gid = wgid / nig, fm = gid * WGM, gsz = (nM - fm) < WGM ? (nM - fm) : WGM;
        u.pm = fm + ((wgid % nig) % gsz); u.pn = (wgid % nig) / gsz; return true;
    }
    __device__ __forceinline__ void a_ready(const Unit&) const {}
    __device__ __forceinline__ void done(const Unit&) const {}
};

__device__ __forceinline__ unsigned cvt_pk_bf16(float lo, float hi) { unsigned r; asm volatile("v_cvt_pk_bf16_f32 %0, %1, %2" : "=v"(r) : "v"(lo), "v"(hi)); return r; }
typedef float f32x2 __attribute__((ext_vector_type(2)));
__device__ __forceinline__ f32x2 gelu_pk(f32x2 v) {
    const f32x2 av = __builtin_elementwise_abs(v), d = av * 0.2316418882f + 1.0f;
    f32x2 t; t.x = __builtin_amdgcn_rcpf(d.x); t.y = __builtin_amdgcn_rcpf(d.y);
    f32x2 q = t * 0.5307027145f + (-0.7265760135f); q = q * t + 0.7107068705f; q = q * t + (-0.142248368f); q = q * t + 0.127414796f; q = q * t;
    const f32x2 s = (v * v) * (-0.72134752044f);
    f32x2 e; e.x = __builtin_amdgcn_exp2f(s.x); e.y = __builtin_amdgcn_exp2f(s.y);
    const f32x2 m = v * (q * e), r = v - m;
    f32x2 o; o.x = v.x < 0.f ? m.x : r.x; o.y = v.y < 0.f ? m.y : r.y; return o;
}

template <int ACT  > struct EpiBf16 {
    static constexpr bool PERM = true, AFTER_DRAIN = false; static_assert(ACT == 0 || ACT == 1, "EpiBf16: ACT is 0 (none) or 1 (gelu_pk)");
    bf16_t* O; int ldc; const float* bias; int split_cols; size_t split_stride; float scale0;
    __device__ __forceinline__ void operator()(const f32x4 (&acc)[2][2][4][2], const Unit& u, int wr, int wc, int fr, int fq) const {
        const int row0 = u.pm * BM + wr * 64 + fr; int colt = u.pn * BM; bf16_t* base = O;
        float sc = 1.f; if (split_cols) { const int t = colt / split_cols; base += (size_t)t * split_stride; colt -= t * split_cols; if (t == 0) sc = scale0; }
        const int col0 = colt + wc * 32 + 8 * fq, bcol0 = u.pn * BM + wc * 32 + 8 * fq;
        f32x4 bv[2][2];
#pragma unroll
        for (int bj = 0; bj < 2; ++bj)
#pragma unroll
            for (int n = 0; n < 2; ++n) bv[bj][n] = bias ? *(const f32x4*)(bias + bcol0 + bj * HALF + 4 * n) : (f32x4){0.f, 0.f, 0.f, 0.f};
#pragma unroll
        for (int ai = 0; ai < 2; ++ai)
#pragma unroll
            for (int m = 0; m < 4; ++m) { bf16_t* rowp = base + (size_t)(row0 + ai * HALF + m * 16) * ldc + col0;
#pragma unroll
                for (int bj = 0; bj < 2; ++bj) { f32x4 v0 = acc[ai][bj][m][0] + bv[bj][0], v1 = acc[ai][bj][m][1] + bv[bj][1];
                    if (ACT == 1) { f32x2 a = gelu_pk((f32x2){v0[0], v0[1]}), b = gelu_pk((f32x2){v0[2], v0[3]}), c = gelu_pk((f32x2){v1[0], v1[1]}), d = gelu_pk((f32x2){v1[2], v1[3]});
                        v0 = (f32x4){a.x, a.y, b.x, b.y}; v1 = (f32x4){c.x, c.y, d.x, d.y}; }
                    v0 = v0 * sc; v1 = v1 * sc; u32x4 w; w.x = cvt_pk_bf16(v0[0], v0[1]); w.y = cvt_pk_bf16(v0[2], v0[3]); w.z = cvt_pk_bf16(v1[0], v1[1]); w.w = cvt_pk_bf16(v1[2], v1[3]);
                    *(u32x4*)(rowp + bj * HALF) = w; } }
    }
};
template <class Epi, class Sched, bool ALIGN_EPI = false, bool SP2 = false>
__device__ __forceinline__ void gemm_phase(PG8_LAS unsigned char* lds, const Gemm g, const Sched& S, const Epi& E, int tid_in) {
    const int tid = tid_in, wid = __builtin_amdgcn_readfirstlane(tid >> 6), lane = tid & 63, wr = wid >> 2, wc = wid & 3, fr = lane & 15, fq = lane >> 4;
    const int K = g.K, nt = K / BK;
    unsigned voffA[2], voffB[2];
#pragma unroll
    for (int i = 0; i < 2; ++i) { int R, C; stage_rc(tid * 16 + i * 8192, R, C); const int Rb = Epi::PERM ? ((R & ~31) + perm32(R & 31)) : R;
        voffA[i] = (unsigned)(R * K + C) * 2u; voffB[i] = (unsigned)(Rb * K + C) * 2u; }
    const size_t kstep = (size_t)(BK * 2);
    const size_t hstep = (size_t)HALF * K * 2;
    const size_t tstep = 2 * hstep;
    const unsigned ldsw = (unsigned)wid * 1024u;
    const int aoff = lds_byte(wr * 64 + fr, fq * 8), boff = lds_byte(wc * 32 + fr, fq * 8);
#define PG8_SA(b, h) (((b) * 2 + (h)) * HTB)
#define PG8_SB(b, h) ((4 + (b) * 2 + (h)) * HTB)
#define PG8_STAGE(bufoff, gbase, voff) do { _Pragma("unroll") for (int _i = 0; _i < 2; ++_i) \
        __builtin_amdgcn_global_load_lds((const unsigned*)((const char*)(gbase) + (voff)[_i]), (PG8_LAS unsigned*)(lds + (bufoff) + ldsw + _i * 8192), 16, 0, 0); } while (0)
#define PG8_LDA(dst, b, h) do { _Pragma("unroll") for (int m = 0; m < 4; ++m) _Pragma("unroll") for (int k = 0; k < 2; ++k) dst[m][k] = *(const PG8_LAS bf16x8*)(lds + PG8_SA(b, h) + aoff + m * 2048 + k * 1024); } while (0)
#define PG8_LDB(dst, b, h) do { _Pragma("unroll") for (int n = 0; n < 2; ++n) _Pragma("unroll") for (int k = 0; k < 2; ++k) dst[n][k] = *(const PG8_LAS bf16x8*)(lds + PG8_SB(b, h) + boff + n * 2048 + k * 1024); } while (0)
#define PG8_MMA(ai, bj, At, Bt) do { __builtin_amdgcn_s_setprio(1); _Pragma("unroll") for (int m = 0; m < 4; ++m) _Pragma("unroll") for (int n = 0; n < 2; ++n) _Pragma("unroll") for (int k = 0; k < 2; ++k) \
        acc[ai][bj][m][n] = __builtin_amdgcn_mfma_f32_16x16x32_bf16(Bt[n][k], At[m][k], acc[ai][bj][m][n], 0, 0, 0); __builtin_amdgcn_s_setprio(0); } while (0)
#define PG8_WAIT_V(n) asm volatile("s_waitcnt vmcnt(" #n ")" ::: "memory")
#define PG8_WAIT_L(n) asm volatile("s_waitcnt lgkmcnt(" #n ")" ::: "memory")
#define PG8_BAR __builtin_amdgcn_s_barrier()
#define PG8_SCHED __builtin_amdgcn_sched_barrier(0)
    Unit cur, nxt; int ui = 0;
    if (!S.next(0, cur)) return;
    f32x4 acc[2][2][4][2];
#pragma unroll
    for (int a = 0; a < 2; ++a)
#pragma unroll
        for (int b = 0; b < 2; ++b)
#pragma unroll
            for (int m = 0; m < 4; ++m)
#pragma unroll
                for (int n = 0; n < 2; ++n) acc[a][b][m][n] = (f32x4){0.f, 0.f, 0.f, 0.f};
    bf16x8 At[4][2], B0[2][2], B1[2][2];
    const char* cA = (const char*)g.A + (size_t)cur.pm * tstep; const char* cB = (const char*)g.Bt + (size_t)cur.pn * tstep;
    S.a_ready(cur);
    if constexpr (SP2) {
        PG8_STAGE(PG8_SB(0, 0), cB, voffB); PG8_STAGE(PG8_SB(0, 1), cB + hstep, voffB); PG8_STAGE(PG8_SA(0, 0), cA, voffA); PG8_STAGE(PG8_SA(0, 1), cA + hstep, voffA);
        if (wr == 1) PG8_BAR;
        PG8_WAIT_V(2); PG8_BAR;
        PG8_STAGE(PG8_SB(1, 0), cB + kstep, voffB); PG8_STAGE(PG8_SA(1, 0), cA + kstep, voffA); PG8_STAGE(PG8_SB(1, 1), cB + hstep + kstep, voffB);
        PG8_WAIT_V(6); PG8_BAR;
    } else {
        PG8_STAGE(PG8_SB(0, 0), cB, voffB); PG8_STAGE(PG8_SA(0, 0), cA, voffA); PG8_STAGE(PG8_SB(0, 1), cB + hstep, voffB); PG8_STAGE(PG8_SA(0, 1), cA + hstep, voffA);
        if (wr == 1) PG8_BAR;
        PG8_WAIT_V(4); PG8_BAR;
        PG8_STAGE(PG8_SB(1, 0), cB + kstep, voffB); PG8_STAGE(PG8_SA(1, 0), cA + kstep, voffA); PG8_STAGE(PG8_SB(1, 1), cB + hstep + kstep, voffB);
        PG8_WAIT_V(6); PG8_BAR;
    }
    for (;;) {
        const bool has_next = S.next(ui + 1, nxt);
        const char* nA = has_next ? (const char*)g.A + (size_t)nxt.pm * tstep : cA; const char* nB = has_next ? (const char*)g.Bt + (size_t)nxt.pn * tstep : cB;
        for (int t = 0; t < nt; t += 2) {
            const bool last = (t == nt - 2);
            const char* a1 = cA + (size_t)(t + 1) * kstep;
            const char* a2 = last ? nA : cA + (size_t)(t + 2) * kstep; const char* b2 = last ? nB : cB + (size_t)(t + 2) * kstep;
            const char* a3 = a2 + kstep; const char* b3 = b2 + kstep;
            if (last && has_next) S.a_ready(nxt);
            if constexpr (SP2) {
            PG8_LDB(B0, 0, 0); PG8_LDB(B1, 0, 1); PG8_SCHED; PG8_LDA(At, 0, 0); PG8_STAGE(PG8_SA(1, 1), a1 + hstep, voffA);
            PG8_WAIT_V(8); PG8_WAIT_L(0); PG8_BAR; PG8_MMA(0, 0, At, B0); PG8_MMA(0, 1, At, B1); PG8_BAR; PG8_SCHED;
            PG8_LDA(At, 0, 1); PG8_STAGE(PG8_SB(0, 0), b2, voffB); PG8_STAGE(PG8_SB(0, 1), b2 + hstep, voffB); PG8_STAGE(PG8_SA(0, 0), a2, voffA);
            PG8_WAIT_V(8); PG8_WAIT_L(0); PG8_BAR; PG8_MMA(1, 0, At, B0); PG8_MMA(1, 1, At, B1); PG8_BAR; PG8_SCHED;
            PG8_LDB(B0, 1, 0); PG8_LDB(B1, 1, 1); PG8_SCHED; PG8_LDA(At, 1, 0); PG8_STAGE(PG8_SA(0, 1), a2 + hstep, voffA);
            PG8_WAIT_V(8); PG8_WAIT_L(0); PG8_BAR; PG8_MMA(0, 0, At, B0); PG8_MMA(0, 1, At, B1); PG8_BAR; PG8_SCHED;
            PG8_LDA(At, 1, 1); PG8_STAGE(PG8_SB(1, 0), b3, voffB); PG8_STAGE(PG8_SB(1, 1), b3 + hstep, voffB); PG8_STAGE(PG8_SA(1, 0), a3, voffA);
            PG8_WAIT_V(8); PG8_WAIT_L(0); PG8_BAR; PG8_MMA(1, 0, At, B0); PG8_MMA(1, 1, At, B1); PG8_BAR; PG8_SCHED;
            } else {
            PG8_LDB(B0, 0, 0); PG8_SCHED; PG8_LDA(At, 0, 0); PG8_STAGE(PG8_SA(1, 1), a1 + hstep, voffA);
            PG8_WAIT_L(8); PG8_BAR; PG8_WAIT_L(0); PG8_MMA(0, 0, At, B0); PG8_BAR; PG8_SCHED;
            PG8_LDB(B1, 0, 1); PG8_STAGE(PG8_SB(0, 0), b2, voffB);
            PG8_BAR; PG8_WAIT_L(0); PG8_MMA(0, 1, At, B1); PG8_BAR;
            PG8_LDA(At, 0, 1); PG8_STAGE(PG8_SA(0, 0), a2, voffA);
            PG8_BAR; PG8_WAIT_L(0); PG8_MMA(1, 0, At, B0); PG8_BAR; PG8_SCHED;
            PG8_STAGE(PG8_SB(0, 1), b2 + hstep, voffB);
            PG8_WAIT_V(6); PG8_BAR; PG8_MMA(1, 1, At, B1); PG8_BAR;
            PG8_LDB(B0, 1, 0); PG8_SCHED; PG8_LDA(At, 1, 0); PG8_STAGE(PG8_SA(0, 1), a2 + hstep, voffA);
            PG8_WAIT_L(8); PG8_BAR; PG8_WAIT_L(0); PG8_MMA(0, 0, At, B0); PG8_BAR; PG8_SCHED;
            PG8_LDB(B1, 1, 1); PG8_STAGE(PG8_SB(1, 0), b3, voffB);
            PG8_BAR; PG8_WAIT_L(0); PG8_MMA(0, 1, At, B1); PG8_BAR;
            PG8_LDA(At, 1, 1); PG8_STAGE(PG8_SA(1, 0), a3, voffA);
            PG8_BAR; PG8_WAIT_L(0); PG8_MMA(1, 0, At, B0); PG8_BAR; PG8_SCHED;
            PG8_STAGE(PG8_SB(1, 1), b3 + hstep, voffB);
            PG8_WAIT_V(6); PG8_BAR; PG8_MMA(1, 1, At, B1); PG8_BAR;
            }
        }
        if constexpr (ALIGN_EPI) { if (wr == 0) PG8_BAR; }
        if constexpr (!Epi::AFTER_DRAIN) { E(acc, cur, wr, wc, fr, fq); S.done(cur); }
        if (!has_next) break;
#pragma unroll
        for (int a = 0; a < 2; ++a)
#pragma unroll
            for (int b = 0; b < 2; ++b)
#pragma unroll
                for (int m = 0; m < 4; ++m)
#pragma unroll
                    for (int n = 0; n < 2; ++n) acc[a][b][m][n] = (f32x4){0.f, 0.f, 0.f, 0.f};
        cur = nxt; cA = nA; cB = nB; ++ui;
        if constexpr (ALIGN_EPI) { if (wr == 1) PG8_BAR; }
    }
    PG8_WAIT_V(0);
    if constexpr (!ALIGN_EPI) { if (wr == 0) PG8_BAR; }
    PG8_BAR;
    if constexpr (Epi::AFTER_DRAIN) { E.fused(acc, cur, wr, wc, fr, fq, lds, wid, lane); S.done(cur); }
#undef PG8_SA
#undef PG8_SB
#undef PG8_STAGE
#undef PG8_LDA
#undef PG8_LDB
#undef PG8_MMA
#undef PG8_WAIT_V
#undef PG8_WAIT_L
#undef PG8_BAR
#undef PG8_SCHED
}
}

#define LAS __attribute__((address_space(3)))
typedef unsigned short bf16_t;
typedef float f32x4 __attribute__((ext_vector_type(4)));
typedef short bf16x8 __attribute__((ext_vector_type(8)));
typedef unsigned u32x4 __attribute__((ext_vector_type(4)));
typedef unsigned u32x2 __attribute__((ext_vector_type(2)));

constexpr int NWAVES = 8, NTHR = 512;
constexpr int DM = 1024, DFF = 2816, DPROJ = 8704;
constexpr int M_PROMPT = 65536, M_ALL = 81920, GROWS = 16384, NGROUPS = 5;
constexpr int C_AQ = 0, C_AK = 1024, C_AV = 1280, C_HQ = 1536, C_HFF = 2560, C_HFB = 3584, C_HI = 4608, C_HG = 5632, C_GA = 6656, C_GH = 7680;
constexpr float LN_EPS = 1e-5f, RMS_EPS = 1e-6f;
constexpr float DN_ALPHA = 1.189207115002721f;

constexpr size_t MiB = 1u << 20;
constexpr size_t WS_W1IN = 0, WS_W1OUT = 11 * MiB, WS_WIN = 17 * MiB, WS_WOA = 34 * MiB, WS_WOH = 36 * MiB, WS_WOUT = 38 * MiB, WS_W2IN = 40 * MiB, WS_W2OUT = 51 * MiB;
constexpr size_t WS_XB = 64 * MiB;
constexpr size_t WS_H = 224 * MiB;
constexpr size_t WS_PROJ = 224 * MiB;
constexpr size_t WS_ATTO = 496 * MiB;
constexpr size_t WS_HGG = 528 * MiB;
constexpr size_t WS_SLOC = 560 * MiB;
constexpr size_t WS_DLOG = 592 * MiB;
constexpr size_t WS_OF = 594 * MiB;
constexpr size_t WS_OB = 658 * MiB;
constexpr size_t WS_T1 = 722 * MiB;
constexpr size_t WS_MRG = 786 * MiB;
constexpr size_t WS_END = 818 * MiB;
constexpr int LDS_BYTES = 147456;

struct Params { const float* in[19]; float* out; unsigned char* ws; };

__device__ __forceinline__ unsigned f2bf(float f) { unsigned u = __builtin_bit_cast(unsigned, f); return (u + 0x7fffu + ((u >> 16) & 1u)) >> 16; }
__device__ __forceinline__ unsigned pk2(float lo, float hi) { return f2bf(lo) | (f2bf(hi) << 16); }
__device__ __forceinline__ float bf2f(unsigned h) { return __builtin_bit_cast(float, h << 16); }
__device__ __forceinline__ float bflo(unsigned w) { return __builtin_bit_cast(float, w << 16); }
__device__ __forceinline__ float bfhi(unsigned w) { return __builtin_bit_cast(float, w & 0xffff0000u); }
__device__ __forceinline__ float sigmoidf_(float x) { return __builtin_amdgcn_rcpf(1.0f + __expf(-x)); }
__device__ __forceinline__ float siluf_(float x) { return x * sigmoidf_(x); }
__device__ __forceinline__ float wave_sum(float v) {
#pragma unroll
    for (int o = 1; o < 64; o <<= 1) v += __shfl_xor(v, o);
    return v;
}

namespace pg8 {
struct EpiSwiGLU {
    static constexpr bool PERM = true, AFTER_DRAIN = false;
    bf16_t* H; int ldh;
    __device__ __forceinline__ void operator()(const f32x4 (&acc)[2][2][4][2], const Unit& u, int wr, int wc, int fr, int fq) const {
        const int row0 = u.pm * BM + wr * 64 + fr, col0 = u.pn * 128 + wc * 32 + 8 * fq;
#pragma unroll
        for (int ai = 0; ai < 2; ++ai)
#pragma unroll
            for (int m = 0; m < 4; ++m) {
                bf16_t* rowp = H + (size_t)(row0 + ai * HALF + m * 16) * ldh + col0;
                float v[8];
#pragma unroll
                for (int n = 0; n < 2; ++n)
#pragma unroll
                    for (int e = 0; e < 4; ++e) { const float g = acc[ai][0][m][n][e], up = acc[ai][1][m][n][e]; v[n * 4 + e] = g * __builtin_amdgcn_rcpf(1.0f + __expf(-g)) * up; }
                u32x4 w; w.x = cvt_pk_bf16(v[0], v[1]); w.y = cvt_pk_bf16(v[2], v[3]); w.z = cvt_pk_bf16(v[4], v[5]); w.w = cvt_pk_bf16(v[6], v[7]);
                *(u32x4*)rowp = w;
            }
    }
};
struct EpiResid {
    static constexpr bool PERM = false, AFTER_DRAIN = false;
    const float* base0; const float* base1; int split; float* out; float alpha, scale;
    __device__ __forceinline__ void operator()(const f32x4 (&acc)[2][2][4][2], const Unit& u, int wr, int wc, int fr, int fq) const {
        const int row0 = u.pm * BM + wr * 64 + fr, col0 = u.pn * BM + wc * 32 + 4 * fq;
#pragma unroll
        for (int ai = 0; ai < 2; ++ai)
#pragma unroll
            for (int m = 0; m < 4; ++m) {
                const int r = row0 + ai * HALF + m * 16;
                const float* b = (r < split) ? base0 + (size_t)r * 1024 : base1 + (size_t)(r - split) * 1024;
                float* o = out + (size_t)r * 1024;
#pragma unroll
                for (int bj = 0; bj < 2; ++bj)
#pragma unroll
                    for (int n = 0; n < 2; ++n) { const int c = col0 + bj * HALF + n * 16; const f32x4 bs = *(const f32x4*)(b + c);
                        *(f32x4*)(o + c) = bs * alpha + acc[ai][bj][m][n] * scale; }
            }
    }
};
template <bool SECOND> struct EpiGate {
    static constexpr bool PERM = true, AFTER_DRAIN = false;
    const bf16_t* gate; int ldg; float* t1; bf16_t* mrg;
    __device__ __forceinline__ void operator()(const f32x4 (&acc)[2][2][4][2], const Unit& u, int wr, int wc, int fr, int fq) const {
        const int row0 = u.pm * BM + wr * 64 + fr, col0 = u.pn * BM + wc * 32 + 8 * fq;
#pragma unroll
        for (int ai = 0; ai < 2; ++ai)
#pragma unroll
            for (int m = 0; m < 4; ++m) {
                const int r = row0 + ai * HALF + m * 16;
#pragma unroll
                for (int bj = 0; bj < 2; ++bj) {
                    const int c = col0 + bj * HALF;
                    const u32x4 gw = *(const u32x4*)(gate + (size_t)r * ldg + c);
                    float g[8] = {bflo(gw.x), bfhi(gw.x), bflo(gw.y), bfhi(gw.y), bflo(gw.z), bfhi(gw.z), bflo(gw.w), bfhi(gw.w)};
                    float v[8];
#pragma unroll
                    for (int n = 0; n < 2; ++n)
#pragma unroll
                        for (int e = 0; e < 4; ++e) v[n * 4 + e] = __builtin_amdgcn_rcpf(1.0f + __expf(-g[n * 4 + e])) * acc[ai][bj][m][n][e];
                    float* tp = t1 + (size_t)r * 1024 + c;
                    if (!SECOND) { *(f32x4*)tp = (f32x4){v[0], v[1], v[2], v[3]}; *(f32x4*)(tp + 4) = (f32x4){v[4], v[5], v[6], v[7]}; }
                    else { const f32x4 a = *(const f32x4*)tp, b = *(const f32x4*)(tp + 4);
                        u32x4 w; w.x = cvt_pk_bf16(v[0] + a[0], v[1] + a[1]); w.y = cvt_pk_bf16(v[2] + a[2], v[3] + a[3]); w.z = cvt_pk_bf16(v[4] + b[0], v[5] + b[1]); w.w = cvt_pk_bf16(v[6] + b[2], v[7] + b[3]);
                        *(u32x4*)(mrg + (size_t)r * 1024 + c) = w; }
                }
            }
    }
};
}

__device__ __forceinline__ void p0_transpose_item(const float* W, int K, int N, bf16_t* WT, bool swiglu, LAS float* scr, int item, int lane) {
    const int nblk = N / 32, kb = item / nblk, nb = item % nblk, k0 = 64 * kb, n0 = 32 * nb;
    int r0 = n0;
    if (swiglu) { const int isup = n0 >= DFF ? 1 : 0, j = n0 - isup * DFF; r0 = 256 * (j >> 7) + 128 * isup + (j & 127); }
#pragma unroll 8
    for (int i = 0; i < 32; ++i) { const int kk = 2 * i + (lane >> 5); scr[kk * 33 + (lane & 31)] = W[(size_t)(k0 + kk) * N + n0 + (lane & 31)]; }
    asm volatile("s_waitcnt lgkmcnt(0)" ::: "memory");
    const int c = lane & 7;
#pragma unroll
    for (int j = 0; j < 4; ++j) { const int n = (lane >> 3) + 8 * j; const LAS float* s = scr + (8 * c) * 33 + n;
        u32x4 o; o.x = pk2(s[0 * 33], s[1 * 33]); o.y = pk2(s[2 * 33], s[3 * 33]); o.z = pk2(s[4 * 33], s[5 * 33]); o.w = pk2(s[6 * 33], s[7 * 33]);
        *(u32x4*)(WT + (size_t)(r0 + n) * K + k0 + 8 * c) = o; }
    asm volatile("s_waitcnt lgkmcnt(0)" ::: "memory");
}

__device__ __forceinline__ void prologue_phase(const Params& p, LAS unsigned char* lds, int gw, int NGW, int wid, int lane) {
    LAS float* scr = (LAS float*)(lds + wid * 16384);
    unsigned char* ws = p.ws;
    constexpr int I_FIN = (DM / 64) * (2 * DFF / 32), I_FOUT = (DFF / 64) * (DM / 32), I_WIN = (DM / 64) * (DPROJ / 32), I_SQ = (DM / 64) * (DM / 32);
    constexpr int NITEMS = 2 * I_FIN + 2 * I_FOUT + I_WIN + 3 * I_SQ;
    for (int it = gw; it < NITEMS; it += NGW) {
        int r = it;
        if (r < I_FIN) { p0_transpose_item(p.in[2], DM, 2 * DFF, (bf16_t*)(ws + WS_W1IN), true, scr, r, lane); continue; } r -= I_FIN;
        if (r < I_FOUT) { p0_transpose_item(p.in[3], DFF, DM, (bf16_t*)(ws + WS_W1OUT), false, scr, r, lane); continue; } r -= I_FOUT;
        if (r < I_WIN) { p0_transpose_item(p.in[6], DM, DPROJ, (bf16_t*)(ws + WS_WIN), false, scr, r, lane); continue; } r -= I_WIN;
        if (r < I_SQ) { p0_transpose_item(p.in[10], DM, DM, (bf16_t*)(ws + WS_WOA), false, scr, r, lane); continue; } r -= I_SQ;
        if (r < I_SQ) { p0_transpose_item(p.in[11], DM, DM, (bf16_t*)(ws + WS_WOH), false, scr, r, lane); continue; } r -= I_SQ;
        if (r < I_SQ) { p0_transpose_item(p.in[12], DM, DM, (bf16_t*)(ws + WS_WOUT), false, scr, r, lane); continue; } r -= I_SQ;
        if (r < I_FIN) { p0_transpose_item(p.in[15], DM, 2 * DFF, (bf16_t*)(ws + WS_W2IN), true, scr, r, lane); continue; } r -= I_FIN;
        p0_transpose_item(p.in[16], DFF, DM, (bf16_t*)(ws + WS_W2OUT), false, scr, r, lane);
    }
    bf16_t* xb = (bf16_t*)(ws + WS_XB);
    for (int m = gw; m < M_ALL; m += NGW) {
        const float* xr = (m < M_PROMPT) ? p.in[0] + (size_t)m * DM : p.in[1] + (size_t)(m - M_PROMPT) * DM;
        const f32x4* x4 = (const f32x4*)xr + lane;
        u32x2* o8 = (u32x2*)(xb + (size_t)m * DM) + lane;
#pragma unroll
        for (int j = 0; j < 4; ++j) { const f32x4 v = x4[64 * j]; u32x2 w; w.x = pk2(v.x, v.y); w.y = pk2(v.z, v.w); o8[64 * j] = w; }
    }
}

__device__ __forceinline__ void ln_phase(const float* z, float* xo, bf16_t* xbo, const float* g, const float* b, int gw, int NGW, int lane) {
    f32x4 gv[4], bv[4];
#pragma unroll
    for (int j = 0; j < 4; ++j) { gv[j] = ((const f32x4*)g)[lane + 64 * j]; bv[j] = ((const f32x4*)b)[lane + 64 * j]; }
    for (int m = gw; m < M_ALL; m += NGW) {
        const f32x4* xr = (const f32x4*)(z + (size_t)m * DM) + lane;
        f32x4 v[4]; float s = 0.f;
#pragma unroll
        for (int j = 0; j < 4; ++j) { v[j] = xr[64 * j]; s += (v[j].x + v[j].y) + (v[j].z + v[j].w); }
        const float mean = wave_sum(s) * (1.f / DM); float s2 = 0.f;
#pragma unroll
        for (int j = 0; j < 4; ++j) { v[j] = v[j] - mean; s2 += (v[j].x * v[j].x + v[j].y * v[j].y) + (v[j].z * v[j].z + v[j].w * v[j].w); }
        const float rstd = 1.f / sqrtf(wave_sum(s2) * (1.f / DM) + LN_EPS);
        f32x4* o4 = (f32x4*)(xo + (size_t)m * DM) + lane;
#pragma unroll
        for (int j = 0; j < 4; ++j) { const f32x4 y = v[j] * rstd * gv[j] + bv[j]; o4[64 * j] = y;
            if (xbo) { u32x2 w; w.x = pk2(y.x, y.y); w.y = pk2(y.z, y.w); ((u32x2*)(xbo + (size_t)m * DM) + lane)[64 * j] = w; } }
    }
}

__device__ __forceinline__ void fast_sincos(float x, float& s, float& c) {
    const float k = rintf(x * 0.15915494309189535f);
    float r = fmaf(-k, 6.28125f, x); r = fmaf(-k, 1.9353071795864769e-3f, r);
    s = __sinf(r); c = __cosf(r);
}
__device__ __forceinline__ void rope8(u32x4& own, const u32x4& oth, float pos, bool second) {
    const float inv[8] = {1.0f, 0.19392274474868576f, 0.03760603093086393f, 0.007292664737217109f, 0.001414213562373095f, 0.0002742481756762073f, 5.318295896944988e-05f, 1.031338537721246e-05f};
    unsigned ow[4] = {own.x, own.y, own.z, own.w}, tw[4] = {oth.x, oth.y, oth.z, oth.w}, rw[4];
#pragma unroll
    for (int j = 0; j < 4; ++j) {
        float s0, c0, s1, c1; fast_sincos(pos * inv[2 * j], s0, c0); fast_sincos(pos * inv[2 * j + 1], s1, c1);
        if (second) { s0 = -s0; s1 = -s1; }
        const float a0 = bflo(ow[j]) * c0 - bflo(tw[j]) * s0, a1 = bfhi(ow[j]) * c1 - bfhi(tw[j]) * s1;
        rw[j] = pk2(a0, a1);
    }
    own.x = rw[0]; own.y = rw[1]; own.z = rw[2]; own.w = rw[3];
}

__device__ __forceinline__ void attn_phase(LAS unsigned char* lds, const bf16_t* proj, bf16_t* atto, const float* sink, int L, int bid, int G, int tid) {
    const int wid = tid >> 6, lane = tid & 63, fr = lane & 15, fq = lane >> 4;
    constexpr int KS = 144, VS = 784;
    LAS unsigned char* Kl = lds;
    LAS unsigned char* Vl = lds + 384 * KS;
    for (int item = bid; item < 512; item += G) {
        const int qb = item >> 2, kvh = item & 3;
        const int tb = qb * 128, pos0 = tb % L, n = pos0 >> 7, nb = L >> 7;
        const bool vlo = n > 0, vhi = (n + 1) < nb;
        __syncthreads();
        for (int idx = tid; idx < 1536; idx += NTHR) {
            const int r = idx >> 2, qd = idx & 3, blk = r >> 7;
            const bool valid = (blk == 1) || (blk == 0 ? vlo : vhi);
            u32x4 c0 = (u32x4){0u, 0u, 0u, 0u}, c1 = c0;
            if (valid) {
                const bf16_t* src = proj + (size_t)(tb - 128 + r) * DPROJ + C_AK + kvh * 64 + qd * 16;
                c0 = *(const u32x4*)src; c1 = *(const u32x4*)(src + 8);
                if (qd == 0) { const float pos = (float)(pos0 - 128 + r); const u32x4 x1 = c0, x2 = c1; rope8(c0, x2, pos, false); rope8(c1, x1, pos, true); }
            }
            *(LAS u32x4*)(Kl + r * KS + qd * 32) = c0; *(LAS u32x4*)(Kl + r * KS + qd * 32 + 16) = c1;
        }
        for (int idx = tid; idx < 3072; idx += NTHR) {
            const int r = idx % 384, ch = idx / 384, blk = r >> 7;
            const bool valid = (blk == 1) || (blk == 0 ? vlo : vhi);
            u32x4 v = (u32x4){0u, 0u, 0u, 0u};
            if (valid) v = *(const u32x4*)(proj + (size_t)(tb - 128 + r) * DPROJ + C_AV + kvh * 64 + ch * 8);
            const unsigned vw[4] = {v.x, v.y, v.z, v.w};
#pragma unroll
            for (int e = 0; e < 4; ++e) {
                *(LAS unsigned short*)(Vl + (ch * 8 + 2 * e) * VS + r * 2) = (unsigned short)(vw[e] & 0xffffu);
                *(LAS unsigned short*)(Vl + (ch * 8 + 2 * e + 1) * VS + r * 2) = (unsigned short)(vw[e] >> 16);
            }
        }
        __syncthreads();
        const int hq = kvh * 4 + (wid >> 1);
        const float snk = sink[hq];
        for (int rt = 0; rt < 4; ++rt) {
            const int qi0 = (wid & 1) * 64 + rt * 16;
            const int qrow = tb + qi0 + fr;
            const bf16_t* qsrc = proj + (size_t)qrow * DPROJ + C_AQ + hq * 64 + 8 * fq;
            u32x4 q0 = *(const u32x4*)qsrc, q1 = *(const u32x4*)(qsrc + 32);
            {
                u32x4 oth; oth.x = __shfl_xor(q0.x, 16); oth.y = __shfl_xor(q0.y, 16); oth.z = __shfl_xor(q0.z, 16); oth.w = __shfl_xor(q0.w, 16);
                if (fq < 2) rope8(q0, oth, (float)(pos0 + qi0 + fr), fq == 1);
            }
            const bf16x8 qv0 = __builtin_bit_cast(bf16x8, q0), qv1 = __builtin_bit_cast(bf16x8, q1);
            const int qi = qi0 + fr;
            int c_lo = qi0 >> 5, c_hi = (qi0 + 271) >> 5; if (c_hi > 11) c_hi = 11;
            if (!vlo && c_lo < 4) c_lo = 4;
            if (!vhi && c_hi > 7) c_hi = 7;
            float mrow = snk, lsum = 0.f;
            f32x4 o[4];
#pragma unroll
            for (int dt = 0; dt < 4; ++dt) o[dt] = (f32x4){0.f, 0.f, 0.f, 0.f};
#pragma unroll 1
            for (int c = c_lo; c <= c_hi; ++c) {
                f32x4 s2[2];
#pragma unroll
                for (int h = 0; h < 2; ++h) {
                    const int krow = 32 * c + 16 * h + fr;
                    const bf16x8 a0 = *(const LAS bf16x8*)(Kl + krow * KS + fq * 16), a1 = *(const LAS bf16x8*)(Kl + krow * KS + fq * 16 + 64);
                    f32x4 acc = (f32x4){0.f, 0.f, 0.f, 0.f};
                    acc = __builtin_amdgcn_mfma_f32_16x16x32_bf16(a0, qv0, acc, 0, 0, 0);
                    acc = __builtin_amdgcn_mfma_f32_16x16x32_bf16(a1, qv1, acc, 0, 0, 0);
                    s2[h] = acc;
                }
                const bool bv = (c < 4) ? vlo : ((c >= 8) ? vhi : true);
                float mx = -1e30f;
#pragma unroll
                for (int h = 0; h < 2; ++h)
#pragma unroll
                    for (int r = 0; r < 4; ++r) {
                        const int d = 32 * c + 16 * h + 4 * fq + r - 128 - qi;
                        const bool ok = bv && (d <= 128) && (d >= -128);
                        const float v = ok ? s2[h][r] * 0.125f : -1e30f;
                        s2[h][r] = v; mx = fmaxf(mx, v);
                    }
                mx = fmaxf(mx, __shfl_xor(mx, 16)); mx = fmaxf(mx, __shfl_xor(mx, 32));
                const float mnew = fmaxf(mrow, mx), alpha = __expf(mrow - mnew);
                mrow = mnew;
                float ps = 0.f;
#pragma unroll
                for (int h = 0; h < 2; ++h)
#pragma unroll
                    for (int r = 0; r < 4; ++r) { const float e = __expf(s2[h][r] - mnew); s2[h][r] = e; ps += e; }
                lsum = lsum * alpha + ps;
                u32x4 pw; pw.x = pk2(s2[0][0], s2[0][1]); pw.y = pk2(s2[0][2], s2[0][3]); pw.z = pk2(s2[1][0], s2[1][1]); pw.w = pk2(s2[1][2], s2[1][3]);
                const bf16x8 pf = __builtin_bit_cast(bf16x8, pw);
#pragma unroll
                for (int dt = 0; dt < 4; ++dt) {
                    const u32x2 v0 = *(const LAS u32x2*)(Vl + (16 * dt + fr) * VS + (32 * c + 4 * fq) * 2), v1 = *(const LAS u32x2*)(Vl + (16 * dt + fr) * VS + (32 * c + 16 + 4 * fq) * 2);
                    u32x4 vw; vw.x = v0.x; vw.y = v0.y; vw.z = v1.x; vw.w = v1.y;
                    o[dt] = o[dt] * alpha;
                    o[dt] = __builtin_amdgcn_mfma_f32_16x16x32_bf16(__builtin_bit_cast(bf16x8, vw), pf, o[dt], 0, 0, 0);
                }
            }
            lsum += __shfl_xor(lsum, 16); lsum += __shfl_xor(lsum, 32);
            const float invd = 1.0f / (lsum + __expf(snk - mrow));
            bf16_t* dst = atto + (size_t)qrow * DM + hq * 64 + 4 * fq;
#pragma unroll
            for (int dt = 0; dt < 4; ++dt) { u32x2 w; w.x = pk2(o[dt][0] * invd, o[dt][1] * invd); w.y = pk2(o[dt][2] * invd, o[dt][3] * invd); *(u32x2*)(dst + 16 * dt) = w; }
        }
    }
}

template <bool OUT>
__device__ __forceinline__ void hgrn_phase(LAS unsigned char* lds, const bf16_t* proj, const float* lbraw, float* sloc, float* dlog, float* of, float* ob, int bid, int G, int tid) {
    const int wid = tid >> 6, lane = tid & 63, fr = lane & 15, fq = lane >> 4;
    constexpr int QS = 272, TS = 144, SS = 272;
    LAS unsigned char* QD = lds;
    LAS unsigned char* KI = lds + 17408;
    LAS unsigned char* KE = lds + 34816;
    LAS unsigned char* VT = lds + 53248;
    LAS unsigned char* ST = lds + 71680;
    LAS float* QT = (LAS float*)(lds + 106496);
    LAS float* BL = (LAS float*)(lds + 108544);
    const int ch = tid & 127, tq = tid >> 7;
    for (int item = bid; item < 512; item += G) {
        const int seg = item >> 4, head = (item >> 1) & 7, dir = item & 1;
        const float a0 = lbraw[dir * 2048 + head * 128 + ch], a1 = lbraw[dir * 2048 + 1024 + head * 128 + ch];
        const float lb = 1.0f / (1.0f + expf(a1 - a0));
        f32x4 S[8];
        __syncthreads();
        if (OUT) {
            const float* sp = sloc + (size_t)item * 16384 + (16 * wid + fr) * 128 + 4 * fq;
#pragma unroll
            for (int kt = 0; kt < 8; ++kt) { S[kt] = *(const f32x4*)(sp + 16 * kt);
                u32x2 w; w.x = pk2(S[kt][0], S[kt][1]); w.y = pk2(S[kt][2], S[kt][3]); *(LAS u32x2*)(ST + (16 * wid + fr) * SS + (16 * kt + 4 * fq) * 2) = w; }
        } else {
#pragma unroll
            for (int kt = 0; kt < 8; ++kt) S[kt] = (f32x4){0.f, 0.f, 0.f, 0.f};
        }
        float dsum = 0.f;
        const int fcol = (dir ? C_HFB : C_HFF) + head * 128 + ch;
        for (int c = 0; c < 8; ++c) {
            const int c0 = seg * 512 + (dir ? 7 - c : c) * 64;
            __syncthreads();
            float bl[16], kk[16]; float run = 0.f;
#pragma unroll
            for (int e = 0; e < 16; ++e) {
                const int i = 16 * tq + e, t = dir ? c0 + 63 - i : c0 + i;
                const float fz = bf2f(proj[(size_t)t * DPROJ + fcol]);
                const float f = lb + (1.0f - lb) * sigmoidf_(fz);
                run += __logf(f); bl[e] = run; kk[e] = 1.0f - f;
            }
            QT[tq * 128 + ch] = run;
            __syncthreads();
            const float t0 = QT[ch], t1 = QT[128 + ch], t2 = QT[256 + ch], t3 = QT[384 + ch];
            const float tot = (t0 + t1) + (t2 + t3);
            const float offs = (tq > 0 ? t0 : 0.f) + (tq > 1 ? t1 : 0.f) + (tq > 2 ? t2 : 0.f);
            if (tq == 0) BL[ch] = tot;
            dsum += tot;
            unsigned kew[8], vtw[8];
#pragma unroll
            for (int e = 0; e < 16; e += 2) {
                float ke[2]; unsigned vr[2];
#pragma unroll
                for (int h = 0; h < 2; ++h) {
                    const int i = 16 * tq + e + h, t = dir ? c0 + 63 - i : c0 + i;
                    const float b = bl[e + h] + offs;
                    ke[h] = kk[e + h] * __expf(tot - b);
                    const bf16_t* rowp = proj + (size_t)t * DPROJ + head * 128 + ch;
                    vr[h] = rowp[C_HI];
                    if (OUT) {
                        const float q = siluf_(bf2f(rowp[C_HQ]));
                        *(LAS unsigned short*)(QD + i * QS + ch * 2) = (unsigned short)f2bf(q * __expf(b));
                        *(LAS unsigned short*)(KI + i * QS + ch * 2) = (unsigned short)f2bf(kk[e + h] * __expf(-b));
                    }
                }
                kew[e >> 1] = pk2(ke[0], ke[1]); vtw[e >> 1] = vr[0] | (vr[1] << 16);
            }
            *(LAS u32x4*)(KE + ch * TS + tq * 32) = (u32x4){kew[0], kew[1], kew[2], kew[3]}; *(LAS u32x4*)(KE + ch * TS + tq * 32 + 16) = (u32x4){kew[4], kew[5], kew[6], kew[7]};
            *(LAS u32x4*)(VT + ch * TS + tq * 32) = (u32x4){vtw[0], vtw[1], vtw[2], vtw[3]}; *(LAS u32x4*)(VT + ch * TS + tq * 32 + 16) = (u32x4){vtw[4], vtw[5], vtw[6], vtw[7]};
            __syncthreads();
            if (OUT) {
                const int it = wid & 3, dh = wid >> 2;
                bf16x8 qf[4];
#pragma unroll
                for (int cc = 0; cc < 4; ++cc) qf[cc] = *(const LAS bf16x8*)(QD + (16 * it + fr) * QS + (32 * cc + 8 * fq) * 2);
                f32x4 at[4];
#pragma unroll
                for (int jt = 0; jt < 4; ++jt) {
                    f32x4 a = (f32x4){0.f, 0.f, 0.f, 0.f};
#pragma unroll
                    for (int cc = 0; cc < 4; ++cc) { const bf16x8 kf = *(const LAS bf16x8*)(KI + (16 * jt + fr) * QS + (32 * cc + 8 * fq) * 2); a = __builtin_amdgcn_mfma_f32_16x16x32_bf16(kf, qf[cc], a, 0, 0, 0); }
#pragma unroll
                    for (int r = 0; r < 4; ++r) { const int j = 16 * jt + 4 * fq + r, i = 16 * it + fr; if (j > i) a[r] = 0.f; }
                    at[jt] = a;
                }
                bf16x8 pa[2];
#pragma unroll
                for (int jc = 0; jc < 2; ++jc) { u32x4 w; w.x = pk2(at[2 * jc][0], at[2 * jc][1]); w.y = pk2(at[2 * jc][2], at[2 * jc][3]); w.z = pk2(at[2 * jc + 1][0], at[2 * jc + 1][1]); w.w = pk2(at[2 * jc + 1][2], at[2 * jc + 1][3]); pa[jc] = __builtin_bit_cast(bf16x8, w); }
                const int isc = 16 * it + fr, tok = dir ? c0 + 63 - isc : c0 + isc;
                float* dst = (dir ? ob : of) + (size_t)tok * DM + head * 128 + 4 * fq;
#pragma unroll
                for (int d4 = 0; d4 < 4; ++d4) {
                    const int dt = 4 * dh + d4;
                    f32x4 o = (f32x4){0.f, 0.f, 0.f, 0.f};
#pragma unroll
                    for (int jc = 0; jc < 2; ++jc) {
                        const u32x2 v0 = *(const LAS u32x2*)(VT + (16 * dt + fr) * TS + (32 * jc + 4 * fq) * 2), v1 = *(const LAS u32x2*)(VT + (16 * dt + fr) * TS + (32 * jc + 16 + 4 * fq) * 2);
                        u32x4 vw; vw.x = v0.x; vw.y = v0.y; vw.z = v1.x; vw.w = v1.y;
                        o = __builtin_amdgcn_mfma_f32_16x16x32_bf16(__builtin_bit_cast(bf16x8, vw), pa[jc], o, 0, 0, 0);
                    }
#pragma unroll
                    for (int cc = 0; cc < 4; ++cc) { const bf16x8 sf = *(const LAS bf16x8*)(ST + (16 * dt + fr) * SS + (32 * cc + 8 * fq) * 2); o = __builtin_amdgcn_mfma_f32_16x16x32_bf16(sf, qf[cc], o, 0, 0, 0); }
                    *(f32x4*)(dst + 16 * dt) = o;
                }
                __syncthreads();
            }
            bf16x8 vf[2];
#pragma unroll
            for (int tc = 0; tc < 2; ++tc) vf[tc] = *(const LAS bf16x8*)(VT + (16 * wid + fr) * TS + (32 * tc + 8 * fq) * 2);
#pragma unroll
            for (int kt = 0; kt < 8; ++kt) {
                const f32x4 bl4 = *(const LAS f32x4*)(BL + 16 * kt + 4 * fq);
                f32x4 a = S[kt];
                a[0] *= __expf(bl4[0]); a[1] *= __expf(bl4[1]); a[2] *= __expf(bl4[2]); a[3] *= __expf(bl4[3]);
#pragma unroll
                for (int tc = 0; tc < 2; ++tc) { const bf16x8 kef = *(const LAS bf16x8*)(KE + (16 * kt + fr) * TS + (32 * tc + 8 * fq) * 2); a = __builtin_amdgcn_mfma_f32_16x16x32_bf16(kef, vf[tc], a, 0, 0, 0); }
                S[kt] = a;
                if (OUT) { u32x2 w; w.x = pk2(a[0], a[1]); w.y = pk2(a[2], a[3]); *(LAS u32x2*)(ST + (16 * wid + fr) * SS + (16 * kt + 4 * fq) * 2) = w; }
            }
        }
        if (!OUT) {
            float* sp = sloc + (size_t)item * 16384 + (16 * wid + fr) * 128 + 4 * fq;
#pragma unroll
            for (int kt = 0; kt < 8; ++kt) *(f32x4*)(sp + 16 * kt) = S[kt];
            if (tq == 0) dlog[item * 128 + ch] = dsum;
        }
    }
}

__device__ __forceinline__ void hgrn_chain_phase(float* sloc, const float* dlog, int L, int gtid, int NT) {
    const int nseg = L / 512, nseq = GROWS / L, nchain = nseq * 16;
    const int total = nchain * 4096;
    for (int idx = gtid; idx < total; idx += NT) {
        const int chain = idx >> 12, e4 = idx & 4095;
        const int sq = chain >> 4, hd = chain & 15, dir = hd & 1;
        const int dk = (e4 * 4) & 127;
        f32x4 run = (f32x4){0.f, 0.f, 0.f, 0.f};
        for (int s = 0; s < nseg; ++s) {
            const int seg = sq * nseg + (dir ? nseg - 1 - s : s);
            const int item = seg * 16 + hd;
            f32x4* sp = (f32x4*)(sloc + (size_t)item * 16384) + e4;
            const f32x4 tmp = *sp;
            const f32x4 dl = *(const f32x4*)(dlog + item * 128 + dk);
            *sp = run;
            run[0] = __expf(dl[0]) * run[0] + tmp[0]; run[1] = __expf(dl[1]) * run[1] + tmp[1]; run[2] = __expf(dl[2]) * run[2] + tmp[2]; run[3] = __expf(dl[3]) * run[3] + tmp[3];
        }
    }
}

__device__ __forceinline__ void hgrn_combine_phase(const float* of, const float* ob, const bf16_t* proj, const float* normg, bf16_t* hgg, int gw, int NGW, int lane) {
    float ng[16];
#pragma unroll
    for (int e = 0; e < 16; ++e) ng[e] = normg[(lane & 7) * 16 + e];
    for (int t = gw; t < GROWS; t += NGW) {
        const f32x4* a = (const f32x4*)(of + (size_t)t * DM + lane * 16);
        const f32x4* b = (const f32x4*)(ob + (size_t)t * DM + lane * 16);
        float o[16]; float ss = 0.f;
#pragma unroll
        for (int j = 0; j < 4; ++j) { const f32x4 x = a[j] + b[j]; o[4 * j] = x[0]; o[4 * j + 1] = x[1]; o[4 * j + 2] = x[2]; o[4 * j + 3] = x[3]; ss += (x[0] * x[0] + x[1] * x[1]) + (x[2] * x[2] + x[3] * x[3]); }
        ss += __shfl_xor(ss, 1); ss += __shfl_xor(ss, 2); ss += __shfl_xor(ss, 4);
        const float r = 1.0f / sqrtf(ss * (1.0f / 128.0f) + RMS_EPS);
        const u32x4* gp = (const u32x4*)(proj + (size_t)t * DPROJ + C_HG + lane * 16);
        const u32x4 g0 = gp[0], g1 = gp[1];
        const unsigned gwd[8] = {g0.x, g0.y, g0.z, g0.w, g1.x, g1.y, g1.z, g1.w};
        unsigned w[8];
#pragma unroll
        for (int j = 0; j < 8; ++j) { const float v0 = o[2 * j] * r * ng[2 * j] * siluf_(bflo(gwd[j])), v1 = o[2 * j + 1] * r * ng[2 * j + 1] * siluf_(bfhi(gwd[j])); w[j] = pk2(v0, v1); }
        u32x4* dp = (u32x4*)(hgg + (size_t)t * DM + lane * 16);
        dp[0] = (u32x4){w[0], w[1], w[2], w[3]}; dp[1] = (u32x4){w[4], w[5], w[6], w[7]};
    }
}

__global__ void __launch_bounds__(NTHR, 2) fwd_megakernel(Params p_unused) {
    typedef const volatile Params __attribute__((address_space(4))) * KParamsPtr;
    KParamsPtr pp = (KParamsPtr)__builtin_amdgcn_kernarg_segment_ptr();
#define PIN(i) ((const float*)pp->in[i])
#define WSP(off) ((unsigned char*)pp->ws + (off))
    extern __shared__ __attribute__((aligned(16))) unsigned char lds_raw[];
    cg::grid_group grid = cg::this_grid();
    LAS unsigned char* lds = (LAS unsigned char*)lds_raw;
    const int G = gridDim.x, NGW = G * NWAVES;
#define PHASE_VARS int tid = threadIdx.x, bid = blockIdx.x; asm volatile("" : "+v"(tid)); asm volatile("" : "+s"(bid)); const int lane = tid & 63, wid = __builtin_amdgcn_readfirstlane(tid >> 6), gw = bid * NWAVES + wid; (void)lane; (void)gw;
#define xb ((bf16_t*)WSP(WS_XB))
#define hb ((bf16_t*)WSP(WS_H))
#define xres ((float*)pp->out)

    { PHASE_VARS Params p; for (int i = 0; i < 19; ++i) p.in[i] = PIN(i); p.out = (float*)pp->out; p.ws = WSP(0); prologue_phase(p, lds, gw, NGW, wid, lane); }
    grid.sync();

    {
        PHASE_VARS pg8::Gemm g{xb, (const bf16_t*)(WSP(0) + WS_W1IN), M_ALL, 2 * DFF, DM}; pg8::StaticOrder S; S.init(M_ALL, 2 * DFF, G, bid);
        pg8::EpiSwiGLU E{hb, DFF};
        pg8::gemm_phase<pg8::EpiSwiGLU, pg8::StaticOrder, true, true>(lds, g, S, E, tid);
    }
    grid.sync();
    {
        PHASE_VARS pg8::Gemm g{hb, (const bf16_t*)(WSP(0) + WS_W1OUT), M_ALL, DM, DFF}; pg8::StaticOrder S; S.init(M_ALL, DM, G, bid);
        pg8::EpiResid E{PIN(0), PIN(1), M_PROMPT, xres, DN_ALPHA, 0.5f};
        pg8::gemm_phase<pg8::EpiResid, pg8::StaticOrder, true, true>(lds, g, S, E, tid);
    }
    grid.sync();
    { PHASE_VARS ln_phase(xres, xres, xb, PIN(4), PIN(5), gw, NGW, lane); }
    grid.sync();

#define proj ((bf16_t*)WSP(WS_PROJ))
#define atto ((bf16_t*)WSP(WS_ATTO))
#define hgg ((bf16_t*)WSP(WS_HGG))
#define sloc ((float*)WSP(WS_SLOC))
#define dlog ((float*)WSP(WS_DLOG))
#define of ((float*)WSP(WS_OF))
#define ob ((float*)WSP(WS_OB))
#define t1 ((float*)WSP(WS_T1))
#define mrg ((bf16_t*)WSP(WS_MRG))
    for (int grp = 0; grp < NGROUPS; ++grp) {
        const int L = (grp < 4) ? 4096 : 16384;
        const size_t r0 = (size_t)grp * GROWS;
        {
            PHASE_VARS pg8::Gemm g{xb + r0 * DM, (const bf16_t*)(WSP(0) + WS_WIN), GROWS, DPROJ, DM}; pg8::StaticOrder S; S.init(GROWS, DPROJ, G, bid);
            pg8::EpiBf16<0> E{proj, DPROJ, nullptr, 0, 0, 1.f};
            pg8::gemm_phase<pg8::EpiBf16<0>, pg8::StaticOrder, true, true>(lds, g, S, E, tid);
        }
        grid.sync();
        { PHASE_VARS attn_phase(lds, proj, atto, PIN(7), L, bid, G, tid); }
        { PHASE_VARS hgrn_phase<false>(lds, proj, PIN(8), sloc, dlog, of, ob, bid, G, tid); }
        grid.sync();
        { PHASE_VARS hgrn_chain_phase(sloc, dlog, L, bid * NTHR + tid, G * NTHR); }
        grid.sync();
        { PHASE_VARS hgrn_phase<true>(lds, proj, PIN(8), sloc, dlog, of, ob, bid, G, tid); }
        grid.sync();
        { PHASE_VARS hgrn_combine_phase(of, ob, proj, PIN(9), hgg, gw, NGW, lane); }
        grid.sync();
        {
            PHASE_VARS pg8::Gemm g{atto, (const bf16_t*)(WSP(0) + WS_WOA), GROWS, DM, DM}; pg8::StaticOrder S; S.init(GROWS, DM, G, bid);
            pg8::EpiGate<false> E{proj + C_GA, DPROJ, t1, mrg};
            pg8::gemm_phase<pg8::EpiGate<false>, pg8::StaticOrder, true, true>(lds, g, S, E, tid);
        }
        grid.sync();
        {
            PHASE_VARS pg8::Gemm g{hgg, (const bf16_t*)(WSP(0) + WS_WOH), GROWS, DM, DM}; pg8::StaticOrder S; S.init(GROWS, DM, G, bid);
            pg8::EpiGate<true> E{proj + C_GH, DPROJ, t1, mrg};
            pg8::gemm_phase<pg8::EpiGate<true>, pg8::StaticOrder, true, true>(lds, g, S, E, tid);
        }
        grid.sync();
        {
            PHASE_VARS pg8::Gemm g{mrg, (const bf16_t*)(WSP(0) + WS_WOUT), GROWS, DM, DM}; pg8::StaticOrder S; S.init(GROWS, DM, G, bid);
            pg8::EpiResid E{xres + r0 * DM, xres + r0 * DM, 1 << 30, xres + r0 * DM, DN_ALPHA, 1.0f};
            pg8::gemm_phase<pg8::EpiResid, pg8::StaticOrder, true, true>(lds, g, S, E, tid);
        }
        grid.sync();
    }
    { PHASE_VARS ln_phase(xres, xres, xb, PIN(13), PIN(14), gw, NGW, lane); }
    grid.sync();

    {
        PHASE_VARS pg8::Gemm g{xb, (const bf16_t*)(WSP(0) + WS_W2IN), M_ALL, 2 * DFF, DM}; pg8::StaticOrder S; S.init(M_ALL, 2 * DFF, G, bid);
        pg8::EpiSwiGLU E{hb, DFF};
        pg8::gemm_phase<pg8::EpiSwiGLU, pg8::StaticOrder, true, true>(lds, g, S, E, tid);
    }
    grid.sync();
    {
        PHASE_VARS pg8::Gemm g{hb, (const bf16_t*)(WSP(0) + WS_W2OUT), M_ALL, DM, DFF}; pg8::StaticOrder S; S.init(M_ALL, DM, G, bid);
        pg8::EpiResid E{xres, xres, 1 << 30, xres, DN_ALPHA, 0.5f};
        pg8::gemm_phase<pg8::EpiResid, pg8::StaticOrder, true, true>(lds, g, S, E, tid);
    }
    grid.sync();
    { PHASE_VARS ln_phase(xres, xres, nullptr, PIN(17), PIN(18), gw, NGW, lane); }
}

extern "C" void kernel_launch(void* const* d_in, const int* in_sizes, int n_in, void* d_out, int out_size, void* d_ws, size_t ws_size, hipStream_t stream) {
    static int grid = 0;
    if (grid == 0) {
        if (n_in != 19 || out_size != M_ALL * DM || ws_size < WS_END) { fprintf(stderr, "kernel_launch: unexpected shapes (n_in %d out %d ws %zu)\n", n_in, out_size, ws_size); grid = -1; return; }
        int dev = 0, cus = 0, per_cu = 0;
        hipGetDevice(&dev);
        hipDeviceGetAttribute(&cus, hipDeviceAttributeMultiprocessorCount, dev);
        if (hipFuncSetAttribute((const void*)fwd_megakernel, hipFuncAttributeMaxDynamicSharedMemorySize, LDS_BYTES) != hipSuccess) { fprintf(stderr, "kernel_launch: hipFuncSetAttribute failed\n"); grid = -1; return; }
        if (hipOccupancyMaxActiveBlocksPerMultiprocessor(&per_cu, (const void*)fwd_megakernel, NTHR, LDS_BYTES) != hipSuccess || per_cu < 1) { fprintf(stderr, "kernel_launch: occupancy query gives %d\n", per_cu); per_cu = 1; }
        (void)hipGetLastError();
        grid = cus * 1;
        fprintf(stderr, "kernel_launch: grid %d (cus %d, per_cu %d)\n", grid, cus, per_cu);
    }
    if (grid < 0) return;
    Params p{};
    for (int i = 0; i < 19; ++i) p.in[i] = (const float*)d_in[i];
    p.out = (float*)d_out; p.ws = (unsigned char*)d_ws;
    void* args[] = {&p};
    hipError_t e = hipLaunchCooperativeKernel((const void*)fwd_megakernel, dim3(grid), dim3(NTHR), args, LDS_BYTES, stream);
    if (e != hipSuccess) fprintf(stderr, "cooperative launch failed: %s (grid %d)\n", hipGetErrorString(e), grid);
}
```

```cpp
#include <hip/hip_runtime.h>
#include <hip/hip_cooperative_groups.h>
#include <cstdio>
#include <cstdint>
namespace cg = cooperative_groups;
namespace pg8 {
#define PG8_LAS __attribute__((address_space(3)))
typedef unsigned short bf16_t;
typedef short bf16x8 __attribute__((ext_vector_type(8)));
typedef float f32x4 __attribute__((ext_vector_type(4)));
typedef unsigned u32x4 __attribute__((ext_vector_type(4)));
constexpr int BM = 256, BK = 64, HALF = 128, HTB = HALF * BK * 2  , STAGE_BYTES = 8 * HTB, NXCD = 8, WGM = 8;

__host__ __device__ __forceinline__ int lds_byte(int r, int c) { const int st = (r >> 4) * 2 + (c >> 5), rr = r & 15, cc = c & 31, ob = rr * 64 + cc * 2; return st * 1024 + (ob ^ (((ob >> 9) & 1) << 5)); }
__host__ __device__ __forceinline__ void stage_rc(int b, int& R, int& C) { const int st = b / 1024, sb = b % 1024, swz = sb ^ (((sb >> 9) & 1) << 5); R = (st >> 1) * 16 + swz / 64; C = (st & 1) * 32 + (swz % 64) / 2; }
__host__ __device__ __forceinline__ int perm32(int rho) { const int n = rho >> 4, i = rho & 15; return 8 * (i >> 2) + 4 * n + (i & 3); }

struct Unit { int pm, pn; };
struct Gemm { const bf16_t* A; const bf16_t* Bt; int M, N, K; };

struct StaticOrder {
    int nM, nN, nwg, G, c;
    __host__ __device__ void init(int M, int N, int G_, int c_) { nM = M / BM; nN = N / BM; nwg = nM * nN; G = G_; c = c_; }
    __host__ __device__ bool next(int i, Unit& u) const {
        const long L = (long)i * G + c; if (L >= nwg) return false;
        int wgid = (int)L; { const int q = nwg / NXCD, r = nwg % NXCD, xcd = wgid % NXCD, off = wgid / NXCD; wgid = (xcd < r ? xcd * (q + 1) : r * (q + 1) + (xcd - r) * q) + off; }
        const int nig = WGM * nN, gid = wgid / nig, fm = gid * WGM, gsz = (nM - fm) < WGM ? (nM - fm) : WGM;
        u.pm = fm + ((wgid % nig) % gsz); u.pn = (wgid % nig) / gsz; return true;
    }
    __device__ __forceinline__ void a_ready(const Unit&) const {}
    __device__ __forceinline__ void done(const Unit&) const {}
};

__device__ __forceinline__ unsigned cvt_pk_bf16(float lo, float hi) { unsigned r; asm volatile("v_cvt_pk_bf16_f32 %0, %1, %2" : "=v"(r) : "v"(lo), "v"(hi)); return r; }
typedef float f32x2 __attribute__((ext_vector_type(2)));
__device__ __forceinline__ f32x2 gelu_pk(f32x2 v) {
    const f32x2 av = __builtin_elementwise_abs(v), d = av * 0.2316418882f + 1.0f;
    f32x2 t; t.x = __builtin_amdgcn_rcpf(d.x); t.y = __builtin_amdgcn_rcpf(d.y);
    f32x2 q = t * 0.5307027145f + (-0.7265760135f); q = q * t + 0.7107068705f; q = q * t + (-0.142248368f); q = q * t + 0.127414796f; q = q * t;
    const f32x2 s = (v * v) * (-0.72134752044f);
    f32x2 e; e.x = __builtin_amdgcn_exp2f(s.x); e.y = __builtin_amdgcn_exp2f(s.y);
    const f32x2 m = v * (q * e), r = v - m;
    f32x2 o; o.x = v.x < 0.f ? m.x : r.x; o.y = v.y < 0.f ? m.y : r.y; return o;
}

template <int ACT  > struct EpiBf16 {
    static constexpr bool PERM = true, AFTER_DRAIN = false; static_assert(ACT == 0 || ACT == 1, "EpiBf16: ACT is 0 (none) or 1 (gelu_pk)");
    bf16_t* O; int ldc; const float* bias; int split_cols; size_t split_stride; float scale0;
    __device__ __forceinline__ void operator()(const f32x4 (&acc)[2][2][4][2], const Unit& u, int wr, int wc, int fr, int fq) const {
        const int row0 = u.pm * BM + wr * 64 + fr; int colt = u.pn * BM; bf16_t* base = O;
        float sc = 1.f; if (split_cols) { const int t = colt / split_cols; base += (size_t)t * split_stride; colt -= t * split_cols; if (t == 0) sc = scale0; }
        const int col0 = colt + wc * 32 + 8 * fq, bcol0 = u.pn * BM + wc * 32 + 8 * fq;
        f32x4 bv[2][2];
#pragma unroll
        for (int bj = 0; bj < 2; ++bj)
#pragma unroll
            for (int n = 0; n < 2; ++n) bv[bj][n] = bias ? *(const f32x4*)(bias + bcol0 + bj * HALF + 4 * n) : (f32x4){0.f, 0.f, 0.f, 0.f};
#pragma unroll
        for (int ai = 0; ai < 2; ++ai)
#pragma unroll
            for (int m = 0; m < 4; ++m) { bf16_t* rowp = base + (size_t)(row0 + ai * HALF + m * 16) * ldc + col0;
#pragma unroll
                for (int bj = 0; bj < 2; ++bj) { f32x4 v0 = acc[ai][bj][m][0] + bv[bj][0], v1 = acc[ai][bj][m][1] + bv[bj][1];
                    if (ACT == 1) { f32x2 a = gelu_pk((f32x2){v0[0], v0[1]}), b = gelu_pk((f32x2){v0[2], v0[3]}), c = gelu_pk((f32x2){v1[0], v1[1]}), d = gelu_pk((f32x2){v1[2], v1[3]});
                        v0 = (f32x4){a.x, a.y, b.x, b.y}; v1 = (f32x4){c.x, c.y, d.x, d.y}; }
                    v0 = v0 * sc; v1 = v1 * sc; u32x4 w; w.x = cvt_pk_bf16(v0[0], v0[1]); w.y = cvt_pk_bf16(v0[2], v0[3]); w.z = cvt_pk_bf16(v1[0], v1[1]); w.w = cvt_pk_bf16(v1[2], v1[3]);
                    *(u32x4*)(rowp + bj * HALF) = w; } }
    }
};
template <class Epi, class Sched, bool ALIGN_EPI = false, bool SP2 = false>
__device__ __forceinline__ void gemm_phase(PG8_LAS unsigned char* lds, const Gemm g, const Sched& S, const Epi& E, int tid_in) {
    const int tid = tid_in, wid = __builtin_amdgcn_readfirstlane(tid >> 6), lane = tid & 63, wr = wid >> 2, wc = wid & 3, fr = lane & 15, fq = lane >> 4;
    const int K = g.K, nt = K / BK;
    unsigned voffA[2], voffB[2];
#pragma unroll
    for (int i = 0; i < 2; ++i) { int R, C; stage_rc(tid * 16 + i * 8192, R, C); const int Rb = Epi::PERM ? ((R & ~31) + perm32(R & 31)) : R;
        voffA[i] = (unsigned)(R * K + C) * 2u; voffB[i] = (unsigned)(Rb * K + C) * 2u; }
    const size_t kstep = (size_t)(BK * 2);
    const size_t hstep = (size_t)HALF * K * 2;
    const size_t tstep = 2 * hstep;
    const unsigned ldsw = (unsigned)wid * 1024u;
    const int aoff = lds_byte(wr * 64 + fr, fq * 8), boff = lds_byte(wc * 32 + fr, fq * 8);
#define PG8_SA(b, h) (((b) * 2 + (h)) * HTB)
#define PG8_SB(b, h) ((4 + (b) * 2 + (h)) * HTB)
#define PG8_STAGE(bufoff, gbase, voff) do { _Pragma("unroll") for (int _i = 0; _i < 2; ++_i) \
        __builtin_amdgcn_global_load_lds((const unsigned*)((const char*)(gbase) + (voff)[_i]), (PG8_LAS unsigned*)(lds + (bufoff) + ldsw + _i * 8192), 16, 0, 0); } while (0)
#define PG8_LDA(dst, b, h) do { _Pragma("unroll") for (int m = 0; m < 4; ++m) _Pragma("unroll") for (int k = 0; k < 2; ++k) dst[m][k] = *(const PG8_LAS bf16x8*)(lds + PG8_SA(b, h) + aoff + m * 2048 + k * 1024); } while (0)
#define PG8_LDB(dst, b, h) do { _Pragma("unroll") for (int n = 0; n < 2; ++n) _Pragma("unroll") for (int k = 0; k < 2; ++k) dst[n][k] = *(const PG8_LAS bf16x8*)(lds + PG8_SB(b, h) + boff + n * 2048 + k * 1024); } while (0)
#define PG8_MMA(ai, bj, At, Bt) do { __builtin_amdgcn_s_setprio(1); _Pragma("unroll") for (int m = 0; m < 4; ++m) _Pragma("unroll") for (int n = 0; n < 2; ++n) _Pragma("unroll") for (int k = 0; k < 2; ++k) \
        acc[ai][bj][m][n] = __builtin_amdgcn_mfma_f32_16x16x32_bf16(Bt[n][k], At[m][k], acc[ai][bj][m][n], 0, 0, 0); __builtin_amdgcn_s_setprio(0); } while (0)
#define PG8_WAIT_V(n) asm volatile("s_waitcnt vmcnt(" #n ")" ::: "memory")
#define PG8_WAIT_L(n) asm volatile("s_waitcnt lgkmcnt(" #n ")" ::: "memory")
#define PG8_BAR __builtin_amdgcn_s_barrier()
#define PG8_SCHED __builtin_amdgcn_sched_barrier(0)
    Unit cur, nxt; int ui = 0;
    if (!S.next(0, cur)) return;
    f32x4 acc[2][2][4][2];
#pragma unroll
    for (int a = 0; a < 2; ++a)
#pragma unroll
        for (int b = 0; b < 2; ++b)
#pragma unroll
            for (int m = 0; m < 4; ++m)
#pragma unroll
                for (int n = 0; n < 2; ++n) acc[a][b][m][n] = (f32x4){0.f, 0.f, 0.f, 0.f};
    bf16x8 At[4][2], B0[2][2], B1[2][2];
    const char* cA = (const char*)g.A + (size_t)cur.pm * tstep; const char* cB = (const char*)g.Bt + (size_t)cur.pn * tstep;
    S.a_ready(cur);
    if constexpr (SP2) {
        PG8_STAGE(PG8_SB(0, 0), cB, voffB); PG8_STAGE(PG8_SB(0, 1), cB + hstep, voffB); PG8_STAGE(PG8_SA(0, 0), cA, voffA); PG8_STAGE(PG8_SA(0, 1), cA + hstep, voffA);
        if (wr == 1) PG8_BAR;
        PG8_WAIT_V(2); PG8_BAR;
        PG8_STAGE(PG8_SB(1, 0), cB + kstep, voffB); PG8_STAGE(PG8_SA(1, 0), cA + kstep, voffA); PG8_STAGE(PG8_SB(1, 1), cB + hstep + kstep, voffB);
        PG8_WAIT_V(6); PG8_BAR;
    } else {
        PG8_STAGE(PG8_SB(0, 0), cB, voffB); PG8_STAGE(PG8_SA(0, 0), cA, voffA); PG8_STAGE(PG8_SB(0, 1), cB + hstep, voffB); PG8_STAGE(PG8_SA(0, 1), cA + hstep, voffA);
        if (wr == 1) PG8_BAR;
        PG8_WAIT_V(4); PG8_BAR;
        PG8_STAGE(PG8_SB(1, 0), cB + kstep, voffB); PG8_STAGE(PG8_SA(1, 0), cA + kstep, voffA); PG8_STAGE(PG8_SB(1, 1), cB + hstep + kstep, voffB);
        PG8_WAIT_V(6); PG8_BAR;
    }
    for (;;) {
        const bool has_next = S.next(ui + 1, nxt);
        const char* nA = has_next ? (const char*)g.A + (size_t)nxt.pm * tstep : cA; const char* nB = has_next ? (const char*)g.Bt + (size_t)nxt.pn * tstep : cB;
        for (int t = 0; t < nt; t += 2) {
            const bool last = (t == nt - 2);
            const char* a1 = cA + (size_t)(t + 1) * kstep;
            const char* a2 = last ? nA : cA + (size_t)(t + 2) * kstep; const char* b2 = last ? nB : cB + (size_t)(t + 2) * kstep;
            const char* a3 = a2 + kstep; const char* b3 = b2 + kstep;
            if (last && has_next) S.a_ready(nxt);
            if constexpr (SP2) {
            PG8_LDB(B0, 0, 0); PG8_LDB(B1, 0, 1); PG8_SCHED; PG8_LDA(At, 0, 0); PG8_STAGE(PG8_SA(1, 1), a1 + hstep, voffA);
            PG8_WAIT_V(8); PG8_WAIT_L(0); PG8_BAR; PG8_MMA(0, 0, At, B0); PG8_MMA(0, 1, At, B1); PG8_BAR; PG8_SCHED;
            PG8_LDA(At, 0, 1); PG8_STAGE(PG8_SB(0, 0), b2, voffB); PG8_STAGE(PG8_SB(0, 1), b2 + hstep, voffB); PG8_STAGE(PG8_SA(0, 0), a2, voffA);
            PG8_WAIT_V(8); PG8_WAIT_L(0); PG8_BAR; PG8_MMA(1, 0, At, B0); PG8_MMA(1, 1, At, B1); PG8_BAR; PG8_SCHED;
            PG8_LDB(B0, 1, 0); PG8_LDB(B1, 1, 1); PG8_SCHED; PG8_LDA(At, 1, 0); PG8_STAGE(PG8_SA(0, 1), a2 + hstep, voffA);
            PG8_WAIT_V(8); PG8_WAIT_L(0); PG8_BAR; PG8_MMA(0, 0, At, B0); PG8_MMA(0, 1, At, B1); PG8_BAR; PG8_SCHED;
            PG8_LDA(At, 1, 1); PG8_STAGE(PG8_SB(1, 0), b3, voffB); PG8_STAGE(PG8_SB(1, 1), b3 + hstep, voffB); PG8_STAGE(PG8_SA(1, 0), a3, voffA);
            PG8_WAIT_V(8); PG8_WAIT_L(0); PG8_BAR; PG8_MMA(1, 0, At, B0); PG8_MMA(1, 1, At, B1); PG8_BAR; PG8_SCHED;
            } else {
            PG8_LDB(B0, 0, 0); PG8_SCHED; PG8_LDA(At, 0, 0); PG8_STAGE(PG8_SA(1, 1), a1 + hstep, voffA);
            PG8_WAIT_L(8); PG8_BAR; PG8_WAIT_L(0); PG8_MMA(0, 0, At, B0); PG8_BAR; PG8_SCHED;
            PG8_LDB(B1, 0, 1); PG8_STAGE(PG8_SB(0, 0), b2, voffB);
            PG8_BAR; PG8_WAIT_L(0); PG8_MMA(0, 1, At, B1); PG8_BAR;
            PG8_LDA(At, 0, 1); PG8_STAGE(PG8_SA(0, 0), a2, voffA);
            PG8_BAR; PG8_WAIT_L(0); PG8_MMA(1, 0, At, B0); PG8_BAR; PG8_SCHED;
            PG8_STAGE(PG8_SB(0, 1), b2 + hstep, voffB);
            PG8_WAIT_V(6); PG8_BAR; PG8_MMA(1, 1, At, B1); PG8_BAR;
            PG8_LDB(B0, 1, 0); PG8_SCHED; PG8_LDA(At, 1, 0); PG8_STAGE(PG8_SA(0, 1), a2 + hstep, voffA);
            PG8_WAIT_L(8); PG8_BAR; PG8_WAIT_L(0); PG8_MMA(0, 0, At, B0); PG8_BAR; PG8_SCHED;
            PG8_LDB(B1, 1, 1); PG8_STAGE(PG8_SB(1, 0), b3, voffB);
            PG8_BAR; PG8_WAIT_L(0); PG8_MMA(0, 1, At, B1); PG8_BAR;
            PG8_LDA(At, 1, 1); PG8_STAGE(PG8_SA(1, 0), a3, voffA);
            PG8_BAR; PG8_WAIT_L(0); PG8_MMA(1, 0, At, B0); PG8_BAR; PG8_SCHED;
            PG8_STAGE(PG8_SB(1, 1), b3 + hstep, voffB);
            PG8_WAIT_V(6); PG8_BAR; PG8_MMA(1, 1, At, B1); PG8_BAR;
            }
        }
        if constexpr (ALIGN_EPI) { if (wr == 0) PG8_BAR; }
        if constexpr (!Epi::AFTER_DRAIN) { E(acc, cur, wr, wc, fr, fq); S.done(cur); }
        if (!has_next) break;
#pragma unroll
        for (int a = 0; a < 2; ++a)
#pragma unroll
            for (int b = 0; b < 2; ++b)
#pragma unroll
                for (int m = 0; m < 4; ++m)
#pragma unroll
                    for (int n = 0; n < 2; ++n) acc[a][b][m][n] = (f32x4){0.f, 0.f, 0.f, 0.f};
        cur = nxt; cA = nA; cB = nB; ++ui;
        if constexpr (ALIGN_EPI) { if (wr == 1) PG8_BAR; }
    }
    PG8_WAIT_V(0);
    if constexpr (!ALIGN_EPI) { if (wr == 0) PG8_BAR; }
    PG8_BAR;
    if constexpr (Epi::AFTER_DRAIN) { E.fused(acc, cur, wr, wc, fr, fq, lds, wid, lane); S.done(cur); }
#undef PG8_SA
#undef PG8_SB
#undef PG8_STAGE
#undef PG8_LDA
#undef PG8_LDB
#undef PG8_MMA
#undef PG8_WAIT_V
#undef PG8_WAIT_L
#undef PG8_BAR
#undef PG8_SCHED
}
}

#define LAS __attribute__((address_space(3)))
typedef unsigned short bf16_t;
typedef float f32x4 __attribute__((ext_vector_type(4)));
typedef short bf16x8 __attribute__((ext_vector_type(8)));
typedef unsigned u32x4 __attribute__((ext_vector_type(4)));
typedef unsigned u32x2 __attribute__((ext_vector_type(2)));

constexpr int NWAVES = 8, NTHR = 512;
constexpr int DM = 1024, DFF = 2816, DPROJ = 8704;
constexpr int M_PROMPT = 65536, M_ALL = 81920, GROWS = 16384, NGROUPS = 5;
constexpr int C_AQ = 0, C_AK = 1024, C_AV = 1280, C_HQ = 1536, C_HFF = 2560, C_HFB = 3584, C_HI = 4608, C_HG = 5632, C_GA = 6656, C_GH = 7680;
constexpr float LN_EPS = 1e-5f, RMS_EPS = 1e-6f;
constexpr float DN_ALPHA = 1.189207115002721f;

constexpr size_t MiB = 1u << 20;
constexpr size_t WS_W1IN = 0, WS_W1OUT = 11 * MiB, WS_WIN = 17 * MiB, WS_WOA = 34 * MiB, WS_WOH = 36 * MiB, WS_WOUT = 38 * MiB, WS_W2IN = 40 * MiB, WS_W2OUT = 51 * MiB;
constexpr size_t WS_BAR = 60 * MiB;
constexpr size_t WS_XB = 64 * MiB;
constexpr size_t WS_H = 224 * MiB;
constexpr size_t WS_PROJ = 224 * MiB;
constexpr size_t WS_ATTO = 496 * MiB;
constexpr size_t WS_HGG = 528 * MiB;
constexpr size_t WS_SLOC = 560 * MiB;
constexpr size_t WS_DLOG = 592 * MiB;
constexpr size_t WS_OF = 594 * MiB;
constexpr size_t WS_OB = 658 * MiB;
constexpr size_t WS_T1 = 722 * MiB;
constexpr size_t WS_MRG = 786 * MiB;
constexpr size_t WS_END = 818 * MiB;
constexpr int LDS_BYTES = 147456;

struct Params { const float* in[19]; float* out; unsigned char* ws; };

__device__ __forceinline__ unsigned f2bf(float f) { unsigned u = __builtin_bit_cast(unsigned, f); return (u + 0x7fffu + ((u >> 16) & 1u)) >> 16; }
__device__ __forceinline__ unsigned pk2(float lo, float hi) { return f2bf(lo) | (f2bf(hi) << 16); }
__device__ __forceinline__ float bf2f(unsigned h) { return __builtin_bit_cast(float, h << 16); }
__device__ __forceinline__ float bflo(unsigned w) { return __builtin_bit_cast(float, w << 16); }
__device__ __forceinline__ float bfhi(unsigned w) { return __builtin_bit_cast(float, w & 0xffff0000u); }
__device__ __forceinline__ float sigmoidf_(float x) { return __builtin_amdgcn_rcpf(1.0f + __expf(-x)); }
__device__ __forceinline__ float siluf_(float x) { return x * sigmoidf_(x); }
__device__ __forceinline__ float wave_sum(float v) {
#pragma unroll
    for (int o = 1; o < 64; o <<= 1) v += __shfl_xor(v, o);
    return v;
}

#define XB_TMO      128
#define XB_XCNT(j)  (256  + 64 * (j))
#define XB_XSUB(j)  (1280 + 64 * (j))
#define XB_XGEN(j)  (2304 + 64 * (j))
#define XB_TOP      3328
#define XB_TOPGEN   3392
#define XCD_BAR_WORDS 3456
#define XB_SPIN_CAP (1u << 18)

__device__ __forceinline__ unsigned xb_ld(unsigned* p)              { return __hip_atomic_load(p, __ATOMIC_RELAXED, __HIP_MEMORY_SCOPE_AGENT); }
__device__ __forceinline__ unsigned xb_add(unsigned* p, unsigned v) { return __hip_atomic_fetch_add(p, v, __ATOMIC_RELAXED, __HIP_MEMORY_SCOPE_AGENT); }
__device__ __forceinline__ unsigned xb_xcc_id() { return (unsigned)__builtin_amdgcn_s_getreg((3 << 11) | 20) & 0xFu; }
#define XB_SPIN(cond, bar) do { unsigned _sp = 0; while (cond) { __builtin_amdgcn_s_sleep(1); \
    if ((++_sp & 255u) == 0u) { if (xb_ld(&(bar)[XB_TMO])) break; if (_sp > XB_SPIN_CAP) { atomicAdd(&(bar)[XB_TMO], 1u); break; } } } } while (0)

struct XcdBarrier {
    unsigned* bar; unsigned x;
    volatile LAS unsigned* st;
};

__device__ __forceinline__ XcdBarrier xcd_barrier_post(unsigned* bar, volatile LAS unsigned* st) {
    XcdBarrier b; b.bar = bar; b.x = xb_xcc_id(); b.st = st;
    if (threadIdx.x == 0) (void)xb_add(&bar[XB_XCNT(b.x)], 1u);
    return b;
}
__device__ __forceinline__ void xcd_barrier_complete(unsigned* bar, unsigned x, unsigned& nloc, unsigned& nx) {
    const unsigned G = gridDim.x * gridDim.y * gridDim.z;
    unsigned sum, cnt, mine, sp = 0u;
    for (;;) {
        sum = 0u; cnt = 0u; mine = 0u;
#pragma unroll
        for (unsigned j = 0; j < 16; ++j) { const unsigned c = xb_ld(&bar[XB_XCNT(j)]); sum += c; cnt += (c > 0u) ? 1u : 0u; mine = (j == x) ? c : mine; }
        if (sum == G) break;
        __builtin_amdgcn_s_sleep(1);
        if ((++sp & 255u) == 0u) { if (xb_ld(&bar[XB_TMO])) break; if (sp > XB_SPIN_CAP) { atomicAdd(&bar[XB_TMO], 1u); break; } }
    }
    nloc = mine > 0u ? mine : 1u; nx = cnt > 0u ? cnt : 1u;
}

__device__ __forceinline__ void xcd_barrier(const XcdBarrier& b) {
    asm volatile("s_waitcnt vmcnt(0)" ::: "memory");
    __syncthreads();
    if (threadIdx.x == 0) {
        unsigned* bar = b.bar;
        __builtin_amdgcn_s_waitcnt(0);
        unsigned nloc = b.st[0], nx = b.st[1];
        if (nloc == 0u) { xcd_barrier_complete(bar, b.x, nloc, nx); b.st[0] = nloc; b.st[1] = nx; }
        const unsigned old = xb_add(&bar[XB_XSUB(b.x)], 1u);
        const unsigned gen = old / nloc;
        if (old + 1u == (gen + 1u) * nloc) {
            __builtin_amdgcn_fence(__ATOMIC_RELEASE, "agent");
            asm volatile("s_waitcnt vmcnt(0)" ::: "memory");
            const unsigned og = xb_add(&bar[XB_TOP], 1u);
            const unsigned tg = og / nx;
            if (og + 1u == (tg + 1u) * nx) xb_add(&bar[XB_TOPGEN], 1u);
            else XB_SPIN(xb_ld(&bar[XB_TOPGEN]) == tg, bar);
            __builtin_amdgcn_fence(__ATOMIC_ACQUIRE, "agent");
            xb_add(&bar[XB_XGEN(b.x)], 1u);
            asm volatile("s_waitcnt vmcnt(0)" ::: "memory");
        } else {
            XB_SPIN(xb_ld(&bar[XB_XGEN(b.x)]) == gen, bar);
            __builtin_amdgcn_fence(__ATOMIC_ACQUIRE, "agent");
            asm volatile("s_waitcnt vmcnt(0)" ::: "memory");
        }
    }
    __syncthreads();
}

namespace pg8 {
struct EpiSwiGLU {
    static constexpr bool PERM = true, AFTER_DRAIN = false;
    bf16_t* H; int ldh;
    __device__ __forceinline__ void operator()(const f32x4 (&acc)[2][2][4][2], const Unit& u, int wr, int wc, int fr, int fq) const {
        const int row0 = u.pm * BM + wr * 64 + fr, col0 = u.pn * 128 + wc * 32 + 8 * fq;
#pragma unroll
        for (int ai = 0; ai < 2; ++ai)
#pragma unroll
            for (int m = 0; m < 4; ++m) {
                bf16_t* rowp = H + (size_t)(row0 + ai * HALF + m * 16) * ldh + col0;
                float v[8];
#pragma unroll
                for (int n = 0; n < 2; ++n)
#pragma unroll
                    for (int e = 0; e < 4; ++e) { const float g = acc[ai][0][m][n][e], up = acc[ai][1][m][n][e]; v[n * 4 + e] = g * __builtin_amdgcn_rcpf(1.0f + __expf(-g)) * up; }
                u32x4 w; w.x = cvt_pk_bf16(v[0], v[1]); w.y = cvt_pk_bf16(v[2], v[3]); w.z = cvt_pk_bf16(v[4], v[5]); w.w = cvt_pk_bf16(v[6], v[7]);
                *(u32x4*)rowp = w;
            }
    }
};
struct EpiResid {
    static constexpr bool PERM = false, AFTER_DRAIN = false;
    const float* base0; const float* base1; int split; float* out; float alpha, scale;
    __device__ __forceinline__ void operator()(const f32x4 (&acc)[2][2][4][2], const Unit& u, int wr, int wc, int fr, int fq) const {
        const int row0 = u.pm * BM + wr * 64 + fr, col0 = u.pn * BM + wc * 32 + 4 * fq;
#pragma unroll
        for (int ai = 0; ai < 2; ++ai)
#pragma unroll
            for (int m = 0; m < 4; ++m) {
                const int r = row0 + ai * HALF + m * 16;
                const float* b = (r < split) ? base0 + (size_t)r * 1024 : base1 + (size_t)(r - split) * 1024;
                float* o = out + (size_t)r * 1024;
#pragma unroll
                for (int bj = 0; bj < 2; ++bj)
#pragma unroll
                    for (int n = 0; n < 2; ++n) { const int c = col0 + bj * HALF + n * 16; const f32x4 bs = *(const f32x4*)(b + c);
                        *(f32x4*)(o + c) = bs * alpha + acc[ai][bj][m][n] * scale; }
            }
    }
};
template <bool SECOND> struct EpiGate {
    static constexpr bool PERM = true, AFTER_DRAIN = false;
    const bf16_t* gate; int ldg; float* t1; bf16_t* mrg;
    __device__ __forceinline__ void operator()(const f32x4 (&acc)[2][2][4][2], const Unit& u, int wr, int wc, int fr, int fq) const {
        const int row0 = u.pm * BM + wr * 64 + fr, col0 = u.pn * BM + wc * 32 + 8 * fq;
#pragma unroll
        for (int ai = 0; ai < 2; ++ai)
#pragma unroll
            for (int m = 0; m < 4; ++m) {
                const int r = row0 + ai * HALF + m * 16;
#pragma unroll
                for (int bj = 0; bj < 2; ++bj) {
                    const int c = col0 + bj * HALF;
                    const u32x4 gw = *(const u32x4*)(gate + (size_t)r * ldg + c);
                    float g[8] = {bflo(gw.x), bfhi(gw.x), bflo(gw.y), bfhi(gw.y), bflo(gw.z), bfhi(gw.z), bflo(gw.w), bfhi(gw.w)};
                    float v[8];
#pragma unroll
                    for (int n = 0; n < 2; ++n)
#pragma unroll
                        for (int e = 0; e < 4; ++e) v[n * 4 + e] = __builtin_amdgcn_rcpf(1.0f + __expf(-g[n * 4 + e])) * acc[ai][bj][m][n][e];
                    float* tp = t1 + (size_t)r * 1024 + c;
                    if (!SECOND) { *(f32x4*)tp = (f32x4){v[0], v[1], v[2], v[3]}; *(f32x4*)(tp + 4) = (f32x4){v[4], v[5], v[6], v[7]}; }
                    else { const f32x4 a = *(const f32x4*)tp, b = *(const f32x4*)(tp + 4);
                        u32x4 w; w.x = cvt_pk_bf16(v[0] + a[0], v[1] + a[1]); w.y = cvt_pk_bf16(v[2] + a[2], v[3] + a[3]); w.z = cvt_pk_bf16(v[4] + b[0], v[5] + b[1]); w.w = cvt_pk_bf16(v[6] + b[2], v[7] + b[3]);
                        *(u32x4*)(mrg + (size_t)r * 1024 + c) = w; }
                }
            }
    }
};
}

__device__ __forceinline__ void p0_transpose_item(const float* W, int K, int N, bf16_t* WT, bool swiglu, LAS float* scr, int item, int lane) {
    const int nblk = N / 32, kb = item / nblk, nb = item % nblk, k0 = 64 * kb, n0 = 32 * nb;
    int r0 = n0;
    if (swiglu) { const int isup = n0 >= DFF ? 1 : 0, j = n0 - isup * DFF; r0 = 256 * (j >> 7) + 128 * isup + (j & 127); }
#pragma unroll 8
    for (int i = 0; i < 32; ++i) { const int kk = 2 * i + (lane >> 5); scr[kk * 33 + (lane & 31)] = W[(size_t)(k0 + kk) * N + n0 + (lane & 31)]; }
    asm volatile("s_waitcnt lgkmcnt(0)" ::: "memory");
    const int c = lane & 7;
#pragma unroll
    for (int j = 0; j < 4; ++j) { const int n = (lane >> 3) + 8 * j; const LAS float* s = scr + (8 * c) * 33 + n;
        u32x4 o; o.x = pk2(s[0 * 33], s[1 * 33]); o.y = pk2(s[2 * 33], s[3 * 33]); o.z = pk2(s[4 * 33], s[5 * 33]); o.w = pk2(s[6 * 33], s[7 * 33]);
        *(u32x4*)(WT + (size_t)(r0 + n) * K + k0 + 8 * c) = o; }
    asm volatile("s_waitcnt lgkmcnt(0)" ::: "memory");
}

__device__ __forceinline__ void prologue_phase(const Params& p, LAS unsigned char* lds, int gw, int NGW, int wid, int lane) {
    LAS float* scr = (LAS float*)(lds + wid * 16384);
    unsigned char* ws = p.ws;
    constexpr int I_FIN = (DM / 64) * (2 * DFF / 32), I_FOUT = (DFF / 64) * (DM / 32), I_WIN = (DM / 64) * (DPROJ / 32), I_SQ = (DM / 64) * (DM / 32);
    constexpr int NITEMS = 2 * I_FIN + 2 * I_FOUT + I_WIN + 3 * I_SQ;
    for (int it = gw; it < NITEMS; it += NGW) {
        int r = it;
        if (r < I_FIN) { p0_transpose_item(p.in[2], DM, 2 * DFF, (bf16_t*)(ws + WS_W1IN), true, scr, r, lane); continue; } r -= I_FIN;
        if (r < I_FOUT) { p0_transpose_item(p.in[3], DFF, DM, (bf16_t*)(ws + WS_W1OUT), false, scr, r, lane); continue; } r -= I_FOUT;
        if (r < I_WIN) { p0_transpose_item(p.in[6], DM, DPROJ, (bf16_t*)(ws + WS_WIN), false, scr, r, lane); continue; } r -= I_WIN;
        if (r < I_SQ) { p0_transpose_item(p.in[10], DM, DM, (bf16_t*)(ws + WS_WOA), false, scr, r, lane); continue; } r -= I_SQ;
        if (r < I_SQ) { p0_transpose_item(p.in[11], DM, DM, (bf16_t*)(ws + WS_WOH), false, scr, r, lane); continue; } r -= I_SQ;
        if (r < I_SQ) { p0_transpose_item(p.in[12], DM, DM, (bf16_t*)(ws + WS_WOUT), false, scr, r, lane); continue; } r -= I_SQ;
        if (r < I_FIN) { p0_transpose_item(p.in[15], DM, 2 * DFF, (bf16_t*)(ws + WS_W2IN), true, scr, r, lane); continue; } r -= I_FIN;
        p0_transpose_item(p.in[16], DFF, DM, (bf16_t*)(ws + WS_W2OUT), false, scr, r, lane);
    }
    bf16_t* xb = (bf16_t*)(ws + WS_XB);
    for (int m = gw; m < M_ALL; m += NGW) {
        const float* xr = (m < M_PROMPT) ? p.in[0] + (size_t)m * DM : p.in[1] + (size_t)(m - M_PROMPT) * DM;
        const f32x4* x4 = (const f32x4*)xr + lane;
        u32x2* o8 = (u32x2*)(xb + (size_t)m * DM) + lane;
#pragma unroll
        for (int j = 0; j < 4; ++j) { const f32x4 v = x4[64 * j]; u32x2 w; w.x = pk2(v.x, v.y); w.y = pk2(v.z, v.w); o8[64 * j] = w; }
    }
}

__device__ __forceinline__ void ln_phase(const float* z, float* xo, bf16_t* xbo, const float* g, const float* b, int gw, int NGW, int lane) {
    f32x4 gv[4], bv[4];
#pragma unroll
    for (int j = 0; j < 4; ++j) { gv[j] = ((const f32x4*)g)[lane + 64 * j]; bv[j] = ((const f32x4*)b)[lane + 64 * j]; }
    for (int m = gw; m < M_ALL; m += NGW) {
        const f32x4* xr = (const f32x4*)(z + (size_t)m * DM) + lane;
        f32x4 v[4]; float s = 0.f;
#pragma unroll
        for (int j = 0; j < 4; ++j) { v[j] = xr[64 * j]; s += (v[j].x + v[j].y) + (v[j].z + v[j].w); }
        const float mean = wave_sum(s) * (1.f / DM); float s2 = 0.f;
#pragma unroll
        for (int j = 0; j < 4; ++j) { v[j] = v[j] - mean; s2 += (v[j].x * v[j].x + v[j].y * v[j].y) + (v[j].z * v[j].z + v[j].w * v[j].w); }
        const float rstd = 1.f / sqrtf(wave_sum(s2) * (1.f / DM) + LN_EPS);
        f32x4* o4 = (f32x4*)(xo + (size_t)m * DM) + lane;
#pragma unroll
        for (int j = 0; j < 4; ++j) { const f32x4 y = v[j] * rstd * gv[j] + bv[j]; o4[64 * j] = y;
            if (xbo) { u32x2 w; w.x = pk2(y.x, y.y); w.y = pk2(y.z, y.w); ((u32x2*)(xbo + (size_t)m * DM) + lane)[64 * j] = w; } }
    }
}

__device__ __forceinline__ void fast_sincos(float x, float& s, float& c) {
    const float k = rintf(x * 0.15915494309189535f);
    float r = fmaf(-k, 6.28125f, x); r = fmaf(-k, 1.9353071795864769e-3f, r);
    s = __sinf(r); c = __cosf(r);
}
__device__ __forceinline__ void rope8(u32x4& own, const u32x4& oth, float pos, bool second) {
    const float inv[8] = {1.0f, 0.19392274474868576f, 0.03760603093086393f, 0.007292664737217109f, 0.001414213562373095f, 0.0002742481756762073f, 5.318295896944988e-05f, 1.031338537721246e-05f};
    unsigned ow[4] = {own.x, own.y, own.z, own.w}, tw[4] = {oth.x, oth.y, oth.z, oth.w}, rw[4];
#pragma unroll
    for (int j = 0; j < 4; ++j) {
        float s0, c0, s1, c1; fast_sincos(pos * inv[2 * j], s0, c0); fast_sincos(pos * inv[2 * j + 1], s1, c1);
        if (second) { s0 = -s0; s1 = -s1; }
        const float a0 = bflo(ow[j]) * c0 - bflo(tw[j]) * s0, a1 = bfhi(ow[j]) * c1 - bfhi(tw[j]) * s1;
        rw[j] = pk2(a0, a1);
    }
    own.x = rw[0]; own.y = rw[1]; own.z = rw[2]; own.w = rw[3];
}

__device__ __forceinline__ void attn_phase(LAS unsigned char* lds, const bf16_t* proj, bf16_t* atto, const float* sink, int L, int bid, int G, int tid) {
    const int wid = tid >> 6, lane = tid & 63, fr = lane & 15, fq = lane >> 4;
    constexpr int KS = 144, VS = 784;
    LAS unsigned char* Kl = lds;
    LAS unsigned char* Vl = lds + 384 * KS;
    for (int item = bid; item < 512; item += G) {
        const int qb = item >> 2, kvh = item & 3;
        const int tb = qb * 128, pos0 = tb % L, n = pos0 >> 7, nb = L >> 7;
        const bool vlo = n > 0, vhi = (n + 1) < nb;
        __syncthreads();
        for (int idx = tid; idx < 1536; idx += NTHR) {
            const int r = idx >> 2, qd = idx & 3, blk = r >> 7;
            const bool valid = (blk == 1) || (blk == 0 ? vlo : vhi);
            u32x4 c0 = (u32x4){0u, 0u, 0u, 0u}, c1 = c0;
            if (valid) {
                const bf16_t* src = proj + (size_t)(tb - 128 + r) * DPROJ + C_AK + kvh * 64 + qd * 16;
                c0 = *(const u32x4*)src; c1 = *(const u32x4*)(src + 8);
                if (qd == 0) { const float pos = (float)(pos0 - 128 + r); const u32x4 x1 = c0, x2 = c1; rope8(c0, x2, pos, false); rope8(c1, x1, pos, true); }
            }
            *(LAS u32x4*)(Kl + r * KS + qd * 32) = c0; *(LAS u32x4*)(Kl + r * KS + qd * 32 + 16) = c1;
        }
        for (int idx = tid; idx < 3072; idx += NTHR) {
            const int r = idx % 384, ch = idx / 384, blk = r >> 7;
            const bool valid = (blk == 1) || (blk == 0 ? vlo : vhi);
            u32x4 v = (u32x4){0u, 0u, 0u, 0u};
            if (valid) v = *(const u32x4*)(proj + (size_t)(tb - 128 + r) * DPROJ + C_AV + kvh * 64 + ch * 8);
            const unsigned vw[4] = {v.x, v.y, v.z, v.w};
#pragma unroll
            for (int e = 0; e < 4; ++e) {
                *(LAS unsigned short*)(Vl + (ch * 8 + 2 * e) * VS + r * 2) = (unsigned short)(vw[e] & 0xffffu);
                *(LAS unsigned short*)(Vl + (ch * 8 + 2 * e + 1) * VS + r * 2) = (unsigned short)(vw[e] >> 16);
            }
        }
        __syncthreads();
        const int hq = kvh * 4 + (wid >> 1);
        const float snk = sink[hq];
        for (int rt = 0; rt < 4; ++rt) {
            const int qi0 = (wid & 1) * 64 + rt * 16;
            const int qrow = tb + qi0 + fr;
            const bf16_t* qsrc = proj + (size_t)qrow * DPROJ + C_AQ + hq * 64 + 8 * fq;
            u32x4 q0 = *(const u32x4*)qsrc, q1 = *(const u32x4*)(qsrc + 32);
            {
                u32x4 oth; oth.x = __shfl_xor(q0.x, 16); oth.y = __shfl_xor(q0.y, 16); oth.z = __shfl_xor(q0.z, 16); oth.w = __shfl_xor(q0.w, 16);
                if (fq < 2) rope8(q0, oth, (float)(pos0 + qi0 + fr), fq == 1);
            }
            const bf16x8 qv0 = __builtin_bit_cast(bf16x8, q0), qv1 = __builtin_bit_cast(bf16x8, q1);
            const int qi = qi0 + fr;
            int c_lo = qi0 >> 5, c_hi = (qi0 + 271) >> 5; if (c_hi > 11) c_hi = 11;
            if (!vlo && c_lo < 4) c_lo = 4;
            if (!vhi && c_hi > 7) c_hi = 7;
            float mrow = snk, lsum = 0.f;
            f32x4 o[4];
#pragma unroll
            for (int dt = 0; dt < 4; ++dt) o[dt] = (f32x4){0.f, 0.f, 0.f, 0.f};
#pragma unroll 1
            for (int c = c_lo; c <= c_hi; ++c) {
                f32x4 s2[2];
#pragma unroll
                for (int h = 0; h < 2; ++h) {
                    const int krow = 32 * c + 16 * h + fr;
                    const bf16x8 a0 = *(const LAS bf16x8*)(Kl + krow * KS + fq * 16), a1 = *(const LAS bf16x8*)(Kl + krow * KS + fq * 16 + 64);
                    f32x4 acc = (f32x4){0.f, 0.f, 0.f, 0.f};
                    acc = __builtin_amdgcn_mfma_f32_16x16x32_bf16(a0, qv0, acc, 0, 0, 0);
                    acc = __builtin_amdgcn_mfma_f32_16x16x32_bf16(a1, qv1, acc, 0, 0, 0);
                    s2[h] = acc;
                }
                const bool bv = (c < 4) ? vlo : ((c >= 8) ? vhi : true);
                float mx = -1e30f;
#pragma unroll
                for (int h = 0; h < 2; ++h)
#pragma unroll
                    for (int r = 0; r < 4; ++r) {
                        const int d = 32 * c + 16 * h + 4 * fq + r - 128 - qi;
                        const bool ok = bv && (d <= 128) && (d >= -128);
                        const float v = ok ? s2[h][r] * 0.125f : -1e30f;
                        s2[h][r] = v; mx = fmaxf(mx, v);
                    }
                mx = fmaxf(mx, __shfl_xor(mx, 16)); mx = fmaxf(mx, __shfl_xor(mx, 32));
                const float mnew = fmaxf(mrow, mx), alpha = __expf(mrow - mnew);
                mrow = mnew;
                float ps = 0.f;
#pragma unroll
                for (int h = 0; h < 2; ++h)
#pragma unroll
                    for (int r = 0; r < 4; ++r) { const float e = __expf(s2[h][r] - mnew); s2[h][r] = e; ps += e; }
                lsum = lsum * alpha + ps;
                u32x4 pw; pw.x = pk2(s2[0][0], s2[0][1]); pw.y = pk2(s2[0][2], s2[0][3]); pw.z = pk2(s2[1][0], s2[1][1]); pw.w = pk2(s2[1][2], s2[1][3]);
                const bf16x8 pf = __builtin_bit_cast(bf16x8, pw);
#pragma unroll
                for (int dt = 0; dt < 4; ++dt) {
                    const u32x2 v0 = *(const LAS u32x2*)(Vl + (16 * dt + fr) * VS + (32 * c + 4 * fq) * 2), v1 = *(const LAS u32x2*)(Vl + (16 * dt + fr) * VS + (32 * c + 16 + 4 * fq) * 2);
                    u32x4 vw; vw.x = v0.x; vw.y = v0.y; vw.z = v1.x; vw.w = v1.y;
                    o[dt] = o[dt] * alpha;
                    o[dt] = __builtin_amdgcn_mfma_f32_16x16x32_bf16(__builtin_bit_cast(bf16x8, vw), pf, o[dt], 0, 0, 0);
                }
            }
            lsum += __shfl_xor(lsum, 16); lsum += __shfl_xor(lsum, 32);
            const float invd = 1.0f / (lsum + __expf(snk - mrow));
            bf16_t* dst = atto + (size_t)qrow * DM + hq * 64 + 4 * fq;
#pragma unroll
            for (int dt = 0; dt < 4; ++dt) { u32x2 w; w.x = pk2(o[dt][0] * invd, o[dt][1] * invd); w.y = pk2(o[dt][2] * invd, o[dt][3] * invd); *(u32x2*)(dst + 16 * dt) = w; }
        }
    }
}

template <bool OUT>
__device__ __forceinline__ void hgrn_phase(LAS unsigned char* lds, const bf16_t* proj, const float* lbraw, float* sloc, float* dlog, float* of, float* ob, int bid, int G, int tid) {
    const int wid = tid >> 6, lane = tid & 63, fr = lane & 15, fq = lane >> 4;
    constexpr int QS = 272, TS = 144, SS = 272;
    LAS unsigned char* QD = lds;
    LAS unsigned char* KI = lds + 17408;
    LAS unsigned char* KE = lds + 34816;
    LAS unsigned char* VT = lds + 53248;
    LAS unsigned char* ST = lds + 71680;
    LAS float* QT = (LAS float*)(lds + 106496);
    LAS float* BL = (LAS float*)(lds + 108544);
    const int ch = tid & 127, tq = tid >> 7;
    for (int item = bid; item < 512; item += G) {
        const int seg = item >> 4, head = (item >> 1) & 7, dir = item & 1;
        const float a0 = lbraw[dir * 2048 + head * 128 + ch], a1 = lbraw[dir * 2048 + 1024 + head * 128 + ch];
        const float lb = 1.0f / (1.0f + expf(a1 - a0));
        f32x4 S[8];
        __syncthreads();
        if (OUT) {
            const float* sp = sloc + (size_t)item * 16384 + (16 * wid + fr) * 128 + 4 * fq;
#pragma unroll
            for (int kt = 0; kt < 8; ++kt) { S[kt] = *(const f32x4*)(sp + 16 * kt);
                u32x2 w; w.x = pk2(S[kt][0], S[kt][1]); w.y = pk2(S[kt][2], S[kt][3]); *(LAS u32x2*)(ST + (16 * wid + fr) * SS + (16 * kt + 4 * fq) * 2) = w; }
        } else {
#pragma unroll
            for (int kt = 0; kt < 8; ++kt) S[kt] = (f32x4){0.f, 0.f, 0.f, 0.f};
        }
        float dsum = 0.f;
        const int fcol = (dir ? C_HFB : C_HFF) + head * 128 + ch;
        for (int c = 0; c < 8; ++c) {
            const int c0 = seg * 512 + (dir ? 7 - c : c) * 64;
            __syncthreads();
            float bl[16], kk[16]; float run = 0.f;
#pragma unroll
            for (int e = 0; e < 16; ++e) {
                const int i = 16 * tq + e, t = dir ? c0 + 63 - i : c0 + i;
                const float fz = bf2f(proj[(size_t)t * DPROJ + fcol]);
                const float f = lb + (1.0f - lb) * sigmoidf_(fz);
                run += __logf(f); bl[e] = run; kk[e] = 1.0f - f;
            }
            QT[tq * 128 + ch] = run;
            __syncthreads();
            const float t0 = QT[ch], t1 = QT[128 + ch], t2 = QT[256 + ch], t3 = QT[384 + ch];
            const float tot = (t0 + t1) + (t2 + t3);
            const float offs = (tq > 0 ? t0 : 0.f) + (tq > 1 ? t1 : 0.f) + (tq > 2 ? t2 : 0.f);
            if (tq == 0) BL[ch] = tot;
            dsum += tot;
            unsigned kew[8], vtw[8];
#pragma unroll
            for (int e = 0; e < 16; e += 2) {
                float ke[2]; unsigned vr[2];
#pragma unroll
                for (int h = 0; h < 2; ++h) {
                    const int i = 16 * tq + e + h, t = dir ? c0 + 63 - i : c0 + i;
                    const float b = bl[e + h] + offs;
                    ke[h] = kk[e + h] * __expf(tot - b);
                    const bf16_t* rowp = proj + (size_t)t * DPROJ + head * 128 + ch;
                    vr[h] = rowp[C_HI];
                    if (OUT) {
                        const float q = siluf_(bf2f(rowp[C_HQ]));
                        *(LAS unsigned short*)(QD + i * QS + ch * 2) = (unsigned short)f2bf(q * __expf(b));
                        *(LAS unsigned short*)(KI + i * QS + ch * 2) = (unsigned short)f2bf(kk[e + h] * __expf(-b));
                    }
                }
                kew[e >> 1] = pk2(ke[0], ke[1]); vtw[e >> 1] = vr[0] | (vr[1] << 16);
            }
            *(LAS u32x4*)(KE + ch * TS + tq * 32) = (u32x4){kew[0], kew[1], kew[2], kew[3]}; *(LAS u32x4*)(KE + ch * TS + tq * 32 + 16) = (u32x4){kew[4], kew[5], kew[6], kew[7]};
            *(LAS u32x4*)(VT + ch * TS + tq * 32) = (u32x4){vtw[0], vtw[1], vtw[2], vtw[3]}; *(LAS u32x4*)(VT + ch * TS + tq * 32 + 16) = (u32x4){vtw[4], vtw[5], vtw[6], vtw[7]};
            __syncthreads();
            if (OUT) {
                const int it = wid & 3, dh = wid >> 2;
                bf16x8 qf[4];
#pragma unroll
                for (int cc = 0; cc < 4; ++cc) qf[cc] = *(const LAS bf16x8*)(QD + (16 * it + fr) * QS + (32 * cc + 8 * fq) * 2);
                f32x4 at[4];
#pragma unroll
                for (int jt = 0; jt < 4; ++jt) {
                    f32x4 a = (f32x4){0.f, 0.f, 0.f, 0.f};
#pragma unroll
                    for (int cc = 0; cc < 4; ++cc) { const bf16x8 kf = *(const LAS bf16x8*)(KI + (16 * jt + fr) * QS + (32 * cc + 8 * fq) * 2); a = __builtin_amdgcn_mfma_f32_16x16x32_bf16(kf, qf[cc], a, 0, 0, 0); }
#pragma unroll
                    for (int r = 0; r < 4; ++r) { const int j = 16 * jt + 4 * fq + r, i = 16 * it + fr; if (j > i) a[r] = 0.f; }
                    at[jt] = a;
                }
                bf16x8 pa[2];
#pragma unroll
                for (int jc = 0; jc < 2; ++jc) { u32x4 w; w.x = pk2(at[2 * jc][0], at[2 * jc][1]); w.y = pk2(at[2 * jc][2], at[2 * jc][3]); w.z = pk2(at[2 * jc + 1][0], at[2 * jc + 1][1]); w.w = pk2(at[2 * jc + 1][2], at[2 * jc + 1][3]); pa[jc] = __builtin_bit_cast(bf16x8, w); }
                const int isc = 16 * it + fr, tok = dir ? c0 + 63 - isc : c0 + isc;
                float* dst = (dir ? ob : of) + (size_t)tok * DM + head * 128 + 4 * fq;
#pragma unroll
                for (int d4 = 0; d4 < 4; ++d4) {
                    const int dt = 4 * dh + d4;
                    f32x4 o = (f32x4){0.f, 0.f, 0.f, 0.f};
#pragma unroll
                    for (int jc = 0; jc < 2; ++jc) {
                        const u32x2 v0 = *(const LAS u32x2*)(VT + (16 * dt + fr) * TS + (32 * jc + 4 * fq) * 2), v1 = *(const LAS u32x2*)(VT + (16 * dt + fr) * TS + (32 * jc + 16 + 4 * fq) * 2);
                        u32x4 vw; vw.x = v0.x; vw.y = v0.y; vw.z = v1.x; vw.w = v1.y;
                        o = __builtin_amdgcn_mfma_f32_16x16x32_bf16(__builtin_bit_cast(bf16x8, vw), pa[jc], o, 0, 0, 0);
                    }
#pragma unroll
                    for (int cc = 0; cc < 4; ++cc) { const bf16x8 sf = *(const LAS bf16x8*)(ST + (16 * dt + fr) * SS + (32 * cc + 8 * fq) * 2); o = __builtin_amdgcn_mfma_f32_16x16x32_bf16(sf, qf[cc], o, 0, 0, 0); }
                    *(f32x4*)(dst + 16 * dt) = o;
                }
                __syncthreads();
            }
            bf16x8 vf[2];
#pragma unroll
            for (int tc = 0; tc < 2; ++tc) vf[tc] = *(const LAS bf16x8*)(VT + (16 * wid + fr) * TS + (32 * tc + 8 * fq) * 2);
#pragma unroll
            for (int kt = 0; kt < 8; ++kt) {
                const f32x4 bl4 = *(const LAS f32x4*)(BL + 16 * kt + 4 * fq);
                f32x4 a = S[kt];
                a[0] *= __expf(bl4[0]); a[1] *= __expf(bl4[1]); a[2] *= __expf(bl4[2]); a[3] *= __expf(bl4[3]);
#pragma unroll
                for (int tc = 0; tc < 2; ++tc) { const bf16x8 kef = *(const LAS bf16x8*)(KE + (16 * kt + fr) * TS + (32 * tc + 8 * fq) * 2); a = __builtin_amdgcn_mfma_f32_16x16x32_bf16(kef, vf[tc], a, 0, 0, 0); }
                S[kt] = a;
                if (OUT) { u32x2 w; w.x = pk2(a[0], a[1]); w.y = pk2(a[2], a[3]); *(LAS u32x2*)(ST + (16 * wid + fr) * SS + (16 * kt + 4 * fq) * 2) = w; }
            }
        }
        if (!OUT) {
            float* sp = sloc + (size_t)item * 16384 + (16 * wid + fr) * 128 + 4 * fq;
#pragma unroll
            for (int kt = 0; kt < 8; ++kt) *(f32x4*)(sp + 16 * kt) = S[kt];
            if (tq == 0) dlog[item * 128 + ch] = dsum;
        }
    }
}

__device__ __forceinline__ void hgrn_chain_phase(float* sloc, const float* dlog, int L, int gtid, int NT) {
    const int nseg = L / 512, nseq = GROWS / L, nchain = nseq * 16;
    const int total = nchain * 4096;
    for (int idx = gtid; idx < total; idx += NT) {
        const int chain = idx >> 12, e4 = idx & 4095;
        const int sq = chain >> 4, hd = chain & 15, dir = hd & 1;
        const int dk = (e4 * 4) & 127;
        f32x4 run = (f32x4){0.f, 0.f, 0.f, 0.f};
        for (int s = 0; s < nseg; ++s) {
            const int seg = sq * nseg + (dir ? nseg - 1 - s : s);
            const int item = seg * 16 + hd;
            f32x4* sp = (f32x4*)(sloc + (size_t)item * 16384) + e4;
            const f32x4 tmp = *sp;
            const f32x4 dl = *(const f32x4*)(dlog + item * 128 + dk);
            *sp = run;
            run[0] = __expf(dl[0]) * run[0] + tmp[0]; run[1] = __expf(dl[1]) * run[1] + tmp[1]; run[2] = __expf(dl[2]) * run[2] + tmp[2]; run[3] = __expf(dl[3]) * run[3] + tmp[3];
        }
    }
}

__device__ __forceinline__ void hgrn_combine_phase(const float* of, const float* ob, const bf16_t* proj, const float* normg, bf16_t* hgg, int gw, int NGW, int lane) {
    float ng[16];
#pragma unroll
    for (int e = 0; e < 16; ++e) ng[e] = normg[(lane & 7) * 16 + e];
    for (int t = gw; t < GROWS; t += NGW) {
        const f32x4* a = (const f32x4*)(of + (size_t)t * DM + lane * 16);
        const f32x4* b = (const f32x4*)(ob + (size_t)t * DM + lane * 16);
        float o[16]; float ss = 0.f;
#pragma unroll
        for (int j = 0; j < 4; ++j) { const f32x4 x = a[j] + b[j]; o[4 * j] = x[0]; o[4 * j + 1] = x[1]; o[4 * j + 2] = x[2]; o[4 * j + 3] = x[3]; ss += (x[0] * x[0] + x[1] * x[1]) + (x[2] * x[2] + x[3] * x[3]); }
        ss += __shfl_xor(ss, 1); ss += __shfl_xor(ss, 2); ss += __shfl_xor(ss, 4);
        const float r = 1.0f / sqrtf(ss * (1.0f / 128.0f) + RMS_EPS);
        const u32x4* gp = (const u32x4*)(proj + (size_t)t * DPROJ + C_HG + lane * 16);
        const u32x4 g0 = gp[0], g1 = gp[1];
        const unsigned gwd[8] = {g0.x, g0.y, g0.z, g0.w, g1.x, g1.y, g1.z, g1.w};
        unsigned w[8];
#pragma unroll
        for (int j = 0; j < 8; ++j) { const float v0 = o[2 * j] * r * ng[2 * j] * siluf_(bflo(gwd[j])), v1 = o[2 * j + 1] * r * ng[2 * j + 1] * siluf_(bfhi(gwd[j])); w[j] = pk2(v0, v1); }
        u32x4* dp = (u32x4*)(hgg + (size_t)t * DM + lane * 16);
        dp[0] = (u32x4){w[0], w[1], w[2], w[3]}; dp[1] = (u32x4){w[4], w[5], w[6], w[7]};
    }
}

#ifndef REP_GEMM
#define REP_GEMM 1
#endif
#ifndef REP_ATTN
#define REP_ATTN 1
#endif
#ifndef REP_HG
#define REP_HG 1
#endif
#define REPEAT(n) for (int rep_ = 0; rep_ < (n); ++rep_)
__global__ void __launch_bounds__(NTHR, 2) fwd_megakernel(Params p_unused) {
    typedef const volatile Params __attribute__((address_space(4))) * KParamsPtr;
    KParamsPtr pp = (KParamsPtr)__builtin_amdgcn_kernarg_segment_ptr();
#define PIN(i) ((const float*)pp->in[i])
#define WSP(off) ((unsigned char*)pp->ws + (off))
    extern __shared__ __attribute__((aligned(16))) unsigned char lds_raw[];
    cg::grid_group grid = cg::this_grid();
    LAS unsigned char* lds = (LAS unsigned char*)lds_raw;
    const int G = gridDim.x, NGW = G * NWAVES;
    volatile LAS unsigned* bar_st = (volatile LAS unsigned*)(lds + 131072 + 512);
    if (threadIdx.x < 4) bar_st[threadIdx.x] = 0u;
    __syncthreads();
    { XcdBarrier b0 = xcd_barrier_post((unsigned*)WSP(WS_BAR), bar_st); (void)b0; }
#define GSYNC() do { XcdBarrier b_; b_.bar = (unsigned*)WSP(WS_BAR); b_.x = xb_xcc_id(); b_.st = bar_st; xcd_barrier(b_); } while (0)
#define PHASE_VARS int tid = threadIdx.x, bid = blockIdx.x; asm volatile("" : "+v"(tid)); asm volatile("" : "+s"(bid)); const int lane = tid & 63, wid = __builtin_amdgcn_readfirstlane(tid >> 6), gw = bid * NWAVES + wid; (void)lane; (void)gw;
#define xb ((bf16_t*)WSP(WS_XB))
#define hb ((bf16_t*)WSP(WS_H))
#define xres ((float*)pp->out)
#define proj ((bf16_t*)WSP(WS_PROJ))
#define atto ((bf16_t*)WSP(WS_ATTO))
#define hgg ((bf16_t*)WSP(WS_HGG))
#define sloc ((float*)WSP(WS_SLOC))
#define dlog ((float*)WSP(WS_DLOG))
#define of ((float*)WSP(WS_OF))
#define ob ((float*)WSP(WS_OB))
#define t1 ((float*)WSP(WS_T1))
#define mrg ((bf16_t*)WSP(WS_MRG))
#define WPTR(off) ((const bf16_t*)WSP(off))

    { PHASE_VARS Params p; for (int i = 0; i < 19; ++i) p.in[i] = PIN(i); p.out = (float*)pp->out; p.ws = WSP(0); prologue_phase(p, lds, gw, NGW, wid, lane); }
    grid.sync();

    REPEAT(REP_GEMM) {
        PHASE_VARS pg8::Gemm g{xb, WPTR(WS_W1IN), M_ALL, 2 * DFF, DM}; pg8::StaticOrder S; S.init(M_ALL, 2 * DFF, G, bid);
        pg8::EpiSwiGLU E{hb, DFF};
        pg8::gemm_phase<pg8::EpiSwiGLU, pg8::StaticOrder, true, true>(lds, g, S, E, tid);
    }
    GSYNC();
    REPEAT(REP_GEMM) {
        PHASE_VARS pg8::Gemm g{hb, WPTR(WS_W1OUT), M_ALL, DM, DFF}; pg8::StaticOrder S; S.init(M_ALL, DM, G, bid);
        pg8::EpiResid E{PIN(0), PIN(1), M_PROMPT, xres, DN_ALPHA, 0.5f};
        pg8::gemm_phase<pg8::EpiResid, pg8::StaticOrder, true, true>(lds, g, S, E, tid);
    }
    GSYNC();
    { PHASE_VARS ln_phase(xres, xres, xb, PIN(4), PIN(5), gw, NGW, lane); }
    GSYNC();

    for (int grp = 0; grp < NGROUPS; ++grp) {
        const int L = (grp < 4) ? 4096 : 16384;
        const size_t r0 = (size_t)grp * GROWS;
        REPEAT(REP_GEMM) {
            PHASE_VARS pg8::Gemm g{xb + r0 * DM, WPTR(WS_WIN), GROWS, DPROJ, DM}; pg8::StaticOrder S; S.init(GROWS, DPROJ, G, bid);
            pg8::EpiBf16<0> E{proj, DPROJ, nullptr, 0, 0, 1.f};
            pg8::gemm_phase<pg8::EpiBf16<0>, pg8::StaticOrder, true, true>(lds, g, S, E, tid);
        }
        GSYNC();
        REPEAT(REP_ATTN) { PHASE_VARS attn_phase(lds, proj, atto, PIN(7), L, bid, G, tid); }
        REPEAT(REP_HG) { PHASE_VARS hgrn_phase<false>(lds, proj, PIN(8), sloc, dlog, of, ob, bid, G, tid); }
        GSYNC();
        { PHASE_VARS hgrn_chain_phase(sloc, dlog, L, bid * NTHR + tid, G * NTHR); }
        GSYNC();
        REPEAT(REP_HG) { PHASE_VARS hgrn_phase<true>(lds, proj, PIN(8), sloc, dlog, of, ob, bid, G, tid); }
        GSYNC();
        REPEAT(REP_HG) { PHASE_VARS hgrn_combine_phase(of, ob, proj, PIN(9), hgg, gw, NGW, lane); }
        GSYNC();
        REPEAT(REP_GEMM) {
            PHASE_VARS pg8::Gemm g{atto, WPTR(WS_WOA), GROWS, DM, DM}; pg8::StaticOrder S; S.init(GROWS, DM, G, bid);
            pg8::EpiGate<false> E{proj + C_GA, DPROJ, t1, mrg};
            pg8::gemm_phase<pg8::EpiGate<false>, pg8::StaticOrder, true, true>(lds, g, S, E, tid);
        }
        GSYNC();
        REPEAT(REP_GEMM) {
            PHASE_VARS pg8::Gemm g{hgg, WPTR(WS_WOH), GROWS, DM, DM}; pg8::StaticOrder S; S.init(GROWS, DM, G, bid);
            pg8::EpiGate<true> E{proj + C_GH, DPROJ, t1, mrg};
            pg8::gemm_phase<pg8::EpiGate<true>, pg8::StaticOrder, true, true>(lds, g, S, E, tid);
        }
        GSYNC();
        {
            PHASE_VARS pg8::Gemm g{mrg, WPTR(WS_WOUT), GROWS, DM, DM}; pg8::StaticOrder S; S.init(GROWS, DM, G, bid);
            pg8::EpiResid E{xres + r0 * DM, xres + r0 * DM, 1 << 30, xres + r0 * DM, DN_ALPHA, 1.0f};
            pg8::gemm_phase<pg8::EpiResid, pg8::StaticOrder, true, true>(lds, g, S, E, tid);
        }
        GSYNC();
    }
    { PHASE_VARS ln_phase(xres, xres, xb, PIN(13), PIN(14), gw, NGW, lane); }
    GSYNC();

    REPEAT(REP_GEMM) {
        PHASE_VARS pg8::Gemm g{xb, WPTR(WS_W2IN), M_ALL, 2 * DFF, DM}; pg8::StaticOrder S; S.init(M_ALL, 2 * DFF, G, bid);
        pg8::EpiSwiGLU E{hb, DFF};
        pg8::gemm_phase<pg8::EpiSwiGLU, pg8::StaticOrder, true, true>(lds, g, S, E, tid);
    }
    GSYNC();
    {
        PHASE_VARS pg8::Gemm g{hb, WPTR(WS_W2OUT), M_ALL, DM, DFF}; pg8::StaticOrder S; S.init(M_ALL, DM, G, bid);
        pg8::EpiResid E{xres, xres, 1 << 30, xres, DN_ALPHA, 0.5f};
        pg8::gemm_phase<pg8::EpiResid, pg8::StaticOrder, true, true>(lds, g, S, E, tid);
    }
    GSYNC();
    { PHASE_VARS ln_phase(xres, xres, nullptr, PIN(17), PIN(18), gw, NGW, lane); }
}

extern "C" void kernel_launch(void* const* d_in, const int* in_sizes, int n_in, void* d_out, int out_size, void* d_ws, size_t ws_size, hipStream_t stream) {
    static int grid = 0;
    if (grid == 0) {
        if (n_in != 19 || out_size != M_ALL * DM || ws_size < WS_END) { fprintf(stderr, "kernel_launch: unexpected shapes (n_in %d out %d ws %zu)\n", n_in, out_size, ws_size); grid = -1; return; }
        int dev = 0, cus = 0, per_cu = 0;
        hipGetDevice(&dev);
        hipDeviceGetAttribute(&cus, hipDeviceAttributeMultiprocessorCount, dev);
        if (hipFuncSetAttribute((const void*)fwd_megakernel, hipFuncAttributeMaxDynamicSharedMemorySize, LDS_BYTES) != hipSuccess) { fprintf(stderr, "kernel_launch: hipFuncSetAttribute failed\n"); grid = -1; return; }
        if (hipOccupancyMaxActiveBlocksPerMultiprocessor(&per_cu, (const void*)fwd_megakernel, NTHR, LDS_BYTES) != hipSuccess || per_cu < 1) { fprintf(stderr, "kernel_launch: occupancy query gives %d\n", per_cu); per_cu = 1; }
        (void)hipGetLastError();
        grid = cus * 1;
        fprintf(stderr, "kernel_launch: grid %d (cus %d, per_cu %d)\n", grid, cus, per_cu);
    }
    if (grid < 0) return;
    Params p{};
    for (int i = 0; i < 19; ++i) p.in[i] = (const float*)d_in[i];
    p.out = (float*)d_out; p.ws = (unsigned char*)d_ws;
    if (hipMemsetAsync((char*)d_ws + WS_BAR, 0, XCD_BAR_WORDS * 4, stream) != hipSuccess) { fprintf(stderr, "kernel_launch: memset failed\n"); return; }
    void* args[] = {&p};
    hipError_t e = hipLaunchCooperativeKernel((const void*)fwd_megakernel, dim3(grid), dim3(NTHR), args, LDS_BYTES, stream);
    if (e != hipSuccess) fprintf(stderr, "cooperative launch failed: %s (grid %d)\n", hipGetErrorString(e), grid);
}
```

```cpp
#include <hip/hip_runtime.h>
#include <hip/hip_cooperative_groups.h>
#include <cstdio>
#include <cstdint>
namespace cg = cooperative_groups;
namespace pg8 {
#define PG8_LAS __attribute__((address_space(3)))
typedef unsigned short bf16_t;
typedef short bf16x8 __attribute__((ext_vector_type(8)));
typedef float f32x4 __attribute__((ext_vector_type(4)));
typedef unsigned u32x4 __attribute__((ext_vector_type(4)));
constexpr int BM = 256, BK = 64, HALF = 128, HTB = HALF * BK * 2  , STAGE_BYTES = 8 * HTB, NXCD = 8, WGM = 8;

__host__ __device__ __forceinline__ int lds_byte(int r, int c) { const int st = (r >> 4) * 2 + (c >> 5), rr = r & 15, cc = c & 31, ob = rr * 64 + cc * 2; return st * 1024 + (ob ^ (((ob >> 9) & 1) << 5)); }
__host__ __device__ __forceinline__ void stage_rc(int b, int& R, int& C) { const int st = b / 1024, sb = b % 1024, swz = sb ^ (((sb >> 9) & 1) << 5); R = (st >> 1) * 16 + swz / 64; C = (st & 1) * 32 + (swz % 64) / 2; }
__host__ __device__ __forceinline__ int perm32(int rho) { const int n = rho >> 4, i = rho & 15; return 8 * (i >> 2) + 4 * n + (i & 3); }

struct Unit { int pm, pn; };
struct Gemm { const bf16_t* A; const bf16_t* Bt; int M, N, K; };

struct StaticOrder {
    int nM, nN, nwg, G, c;
    __host__ __device__ void init(int M, int N, int G_, int c_) { nM = M / BM; nN = N / BM; nwg = nM * nN; G = G_; c = c_; }
    __host__ __device__ bool next(int i, Unit& u) const {
        const long L = (long)i * G + c; if (L >= nwg) return false;
        int wgid = (int)L; { const int q = nwg / NXCD, r = nwg % NXCD, xcd = wgid % NXCD, off = wgid / NXCD; wgid = (xcd < r ? xcd * (q + 1) : r * (q + 1) + (xcd - r) * q) + off; }
        const int nig = WGM * nN, gid = wgid / nig, fm = gid * WGM, gsz = (nM - fm) < WGM ? (nM - fm) : WGM;
        u.pm = fm + ((wgid % nig) % gsz); u.pn = (wgid % nig) / gsz; return true;
    }
    __device__ __forceinline__ void a_ready(const Unit&) const {}
    __device__ __forceinline__ void done(const Unit&) const {}
};

__device__ __forceinline__ unsigned cvt_pk_bf16(float lo, float hi) { unsigned r; asm volatile("v_cvt_pk_bf16_f32 %0, %1, %2" : "=v"(r) : "v"(lo), "v"(hi)); return r; }
typedef float f32x2 __attribute__((ext_vector_type(2)));
__device__ __forceinline__ f32x2 gelu_pk(f32x2 v) {
    const f32x2 av = __builtin_elementwise_abs(v), d = av * 0.2316418882f + 1.0f;
    f32x2 t; t.x = __builtin_amdgcn_rcpf(d.x); t.y = __builtin_amdgcn_rcpf(d.y);
    f32x2 q = t * 0.5307027145f + (-0.7265760135f); q = q * t + 0.7107068705f; q = q * t + (-0.142248368f); q = q * t + 0.127414796f; q = q * t;
    const f32x2 s = (v * v) * (-0.72134752044f);
    f32x2 e; e.x = __builtin_amdgcn_exp2f(s.x); e.y = __builtin_amdgcn_exp2f(s.y);
    const f32x2 m = v * (q * e), r = v - m;
    f32x2 o; o.x = v.x < 0.f ? m.x : r.x; o.y = v.y < 0.f ? m.y : r.y; return o;
}

template <int ACT  > struct EpiBf16 {
    static constexpr bool PERM = true, AFTER_DRAIN = false; static_assert(ACT == 0 || ACT == 1, "EpiBf16: ACT is 0 (none) or 1 (gelu_pk)");
    bf16_t* O; int ldc; const float* bias; int split_cols; size_t split_stride; float scale0;
    __device__ __forceinline__ void operator()(const f32x4 (&acc)[2][2][4][2], const Unit& u, int wr, int wc, int fr, int fq) const {
        const int row0 = u.pm * BM + wr * 64 + fr; int colt = u.pn * BM; bf16_t* base = O;
        float sc = 1.f; if (split_cols) { const int t = colt / split_cols; base += (size_t)t * split_stride; colt -= t * split_cols; if (t == 0) sc = scale0; }
        const int col0 = colt + wc * 32 + 8 * fq, bcol0 = u.pn * BM + wc * 32 + 8 * fq;
        f32x4 bv[2][2];
#pragma unroll
        for (int bj = 0; bj < 2; ++bj)
#pragma unroll
            for (int n = 0; n < 2; ++n) bv[bj][n] = bias ? *(const f32x4*)(bias + bcol0 + bj * HALF + 4 * n) : (f32x4){0.f, 0.f, 0.f, 0.f};
#pragma unroll
        for (int ai = 0; ai < 2; ++ai)
#pragma unroll
            for (int m = 0; m < 4; ++m) { bf16_t* rowp = base + (size_t)(row0 + ai * HALF + m * 16) * ldc + col0;
#pragma unroll
                for (int bj = 0; bj < 2; ++bj) { f32x4 v0 = acc[ai][bj][m][0] + bv[bj][0], v1 = acc[ai][bj][m][1] + bv[bj][1];
                    if (ACT == 1) { f32x2 a = gelu_pk((f32x2){v0[0], v0[1]}), b = gelu_pk((f32x2){v0[2], v0[3]}), c = gelu_pk((f32x2){v1[0], v1[1]}), d = gelu_pk((f32x2){v1[2], v1[3]});
                        v0 = (f32x4){a.x, a.y, b.x, b.y}; v1 = (f32x4){c.x, c.y, d.x, d.y}; }
                    v0 = v0 * sc; v1 = v1 * sc; u32x4 w; w.x = cvt_pk_bf16(v0[0], v0[1]); w.y = cvt_pk_bf16(v0[2], v0[3]); w.z = cvt_pk_bf16(v1[0], v1[1]); w.w = cvt_pk_bf16(v1[2], v1[3]);
                    *(u32x4*)(rowp + bj * HALF) = w; } }
    }
};
template <class Epi, class Sched, bool ALIGN_EPI = false, bool SP2 = false>
__device__ __forceinline__ void gemm_phase(PG8_LAS unsigned char* lds, const Gemm g, const Sched& S, const Epi& E, int tid_in) {
    const int tid = tid_in, wid = __builtin_amdgcn_readfirstlane(tid >> 6), lane = tid & 63, wr = wid >> 2, wc = wid & 3, fr = lane & 15, fq = lane >> 4;
    const int K = g.K, nt = K / BK;
    unsigned voffA[2], voffB[2];
#pragma unroll
    for (int i = 0; i < 2; ++i) { int R, C; stage_rc(tid * 16 + i * 8192, R, C); const int Rb = Epi::PERM ? ((R & ~31) + perm32(R & 31)) : R;
        voffA[i] = (unsigned)(R * K + C) * 2u; voffB[i] = (unsigned)(Rb * K + C) * 2u; }
    const size_t kstep = (size_t)(BK * 2);
    const size_t hstep = (size_t)HALF * K * 2;
    const size_t tstep = 2 * hstep;
    const unsigned ldsw = (unsigned)wid * 1024u;
    const int aoff = lds_byte(wr * 64 + fr, fq * 8), boff = lds_byte(wc * 32 + fr, fq * 8);
#define PG8_SA(b, h) (((b) * 2 + (h)) * HTB)
#define PG8_SB(b, h) ((4 + (b) * 2 + (h)) * HTB)
#define PG8_STAGE(bufoff, gbase, voff) do { _Pragma("unroll") for (int _i = 0; _i < 2; ++_i) \
        __builtin_amdgcn_global_load_lds((const unsigned*)((const char*)(gbase) + (voff)[_i]), (PG8_LAS unsigned*)(lds + (bufoff) + ldsw + _i * 8192), 16, 0, 0); } while (0)
#define PG8_LDA(dst, b, h) do { _Pragma("unroll") for (int m = 0; m < 4; ++m) _Pragma("unroll") for (int k = 0; k < 2; ++k) dst[m][k] = *(const PG8_LAS bf16x8*)(lds + PG8_SA(b, h) + aoff + m * 2048 + k * 1024); } while (0)
#define PG8_LDB(dst, b, h) do { _Pragma("unroll") for (int n = 0; n < 2; ++n) _Pragma("unroll") for (int k = 0; k < 2; ++k) dst[n][k] = *(const PG8_LAS bf16x8*)(lds + PG8_SB(b, h) + boff + n * 2048 + k * 1024); } while (0)
#define PG8_MMA(ai, bj, At, Bt) do { __builtin_amdgcn_s_setprio(1); _Pragma("unroll") for (int m = 0; m < 4; ++m) _Pragma("unroll") for (int n = 0; n < 2; ++n) _Pragma("unroll") for (int k = 0; k < 2; ++k) \
        acc[ai][bj][m][n] = __builtin_amdgcn_mfma_f32_16x16x32_bf16(Bt[n][k], At[m][k], acc[ai][bj][m][n], 0, 0, 0); __builtin_amdgcn_s_setprio(0); } while (0)
#define PG8_WAIT_V(n) asm volatile("s_waitcnt vmcnt(" #n ")" ::: "memory")
#define PG8_WAIT_L(n) asm volatile("s_waitcnt lgkmcnt(" #n ")" ::: "memory")
#define PG8_BAR __builtin_amdgcn_s_barrier()
#define PG8_SCHED __builtin_amdgcn_sched_barrier(0)
    Unit cur, nxt; int ui = 0;
    if (!S.next(0, cur)) return;
    f32x4 acc[2][2][4][2];
#pragma unroll
    for (int a = 0; a < 2; ++a)
#pragma unroll
        for (int b = 0; b < 2; ++b)
#pragma unroll
            for (int m = 0; m < 4; ++m)
#pragma unroll
                for (int n = 0; n < 2; ++n) acc[a][b][m][n] = (f32x4){0.f, 0.f, 0.f, 0.f};
    bf16x8 At[4][2], B0[2][2], B1[2][2];
    const char* cA = (const char*)g.A + (size_t)cur.pm * tstep; const char* cB = (const char*)g.Bt + (size_t)cur.pn * tstep;
    S.a_ready(cur);
    if constexpr (SP2) {
        PG8_STAGE(PG8_SB(0, 0), cB, voffB); PG8_STAGE(PG8_SB(0, 1), cB + hstep, voffB); PG8_STAGE(PG8_SA(0, 0), cA, voffA); PG8_STAGE(PG8_SA(0, 1), cA + hstep, voffA);
        if (wr == 1) PG8_BAR;
        PG8_WAIT_V(2); PG8_BAR;
        PG8_STAGE(PG8_SB(1, 0), cB + kstep, voffB); PG8_STAGE(PG8_SA(1, 0), cA + kstep, voffA); PG8_STAGE(PG8_SB(1, 1), cB + hstep + kstep, voffB);
        PG8_WAIT_V(6); PG8_BAR;
    } else {
        PG8_STAGE(PG8_SB(0, 0), cB, voffB); PG8_STAGE(PG8_SA(0, 0), cA, voffA); PG8_STAGE(PG8_SB(0, 1), cB + hstep, voffB); PG8_STAGE(PG8_SA(0, 1), cA + hstep, voffA);
        if (wr == 1) PG8_BAR;
        PG8_WAIT_V(4); PG8_BAR;
        PG8_STAGE(PG8_SB(1, 0), cB + kstep, voffB); PG8_STAGE(PG8_SA(1, 0), cA + kstep, voffA); PG8_STAGE(PG8_SB(1, 1), cB + hstep + kstep, voffB);
        PG8_WAIT_V(6); PG8_BAR;
    }
    for (;;) {
        const bool has_next = S.next(ui + 1, nxt);
        const char* nA = has_next ? (const char*)g.A + (size_t)nxt.pm * tstep : cA; const char* nB = has_next ? (const char*)g.Bt + (size_t)nxt.pn * tstep : cB;
        for (int t = 0; t < nt; t += 2) {
            const bool last = (t == nt - 2);
            const char* a1 = cA + (size_t)(t + 1) * kstep;
            const char* a2 = last ? nA : cA + (size_t)(t + 2) * kstep; const char* b2 = last ? nB : cB + (size_t)(t + 2) * kstep;
            const char* a3 = a2 + kstep; const char* b3 = b2 + kstep;
            if (last && has_next) S.a_ready(nxt);
            if constexpr (SP2) {
            PG8_LDB(B0, 0, 0); PG8_LDB(B1, 0, 1); PG8_SCHED; PG8_LDA(At, 0, 0); PG8_STAGE(PG8_SA(1, 1), a1 + hstep, voffA);
            PG8_WAIT_V(8); PG8_WAIT_L(0); PG8_BAR; PG8_MMA(0, 0, At, B0); PG8_MMA(0, 1, At, B1); PG8_BAR; PG8_SCHED;
            PG8_LDA(At, 0, 1); PG8_STAGE(PG8_SB(0, 0), b2, voffB); PG8_STAGE(PG8_SB(0, 1), b2 + hstep, voffB); PG8_STAGE(PG8_SA(0, 0), a2, voffA);
            PG8_WAIT_V(8); PG8_WAIT_L(0); PG8_BAR; PG8_MMA(1, 0, At, B0); PG8_MMA(1, 1, At, B1); PG8_BAR; PG8_SCHED;
            PG8_LDB(B0, 1, 0); PG8_LDB(B1, 1, 1); PG8_SCHED; PG8_LDA(At, 1, 0); PG8_STAGE(PG8_SA(0, 1), a2 + hstep, voffA);
            PG8_WAIT_V(8); PG8_WAIT_L(0); PG8_BAR; PG8_MMA(0, 0, At, B0); PG8_MMA(0, 1, At, B1); PG8_BAR; PG8_SCHED;
            PG8_LDA(At, 1, 1); PG8_STAGE(PG8_SB(1, 0), b3, voffB); PG8_STAGE(PG8_SB(1, 1), b3 + hstep, voffB); PG8_STAGE(PG8_SA(1, 0), a3, voffA);
            PG8_WAIT_V(8); PG8_WAIT_L(0); PG8_BAR; PG8_MMA(1, 0, At, B0); PG8_MMA(1, 1, At, B1); PG8_BAR; PG8_SCHED;
            } else {
            PG8_LDB(B0, 0, 0); PG8_SCHED; PG8_LDA(At, 0, 0); PG8_STAGE(PG8_SA(1, 1), a1 + hstep, voffA);
            PG8_WAIT_L(8); PG8_BAR; PG8_WAIT_L(0); PG8_MMA(0, 0, At, B0); PG8_BAR; PG8_SCHED;
            PG8_LDB(B1, 0, 1); PG8_STAGE(PG8_SB(0, 0), b2, voffB);
            PG8_BAR; PG8_WAIT_L(0); PG8_MMA(0, 1, At, B1); PG8_BAR;
            PG8_LDA(At, 0, 1); PG8_STAGE(PG8_SA(0, 0), a2, voffA);
            PG8_BAR; PG8_WAIT_L(0); PG8_MMA(1, 0, At, B0); PG8_BAR; PG8_SCHED;
            PG8_STAGE(PG8_SB(0, 1), b2 + hstep, voffB);
            PG8_WAIT_V(6); PG8_BAR; PG8_MMA(1, 1, At, B1); PG8_BAR;
            PG8_LDB(B0, 1, 0); PG8_SCHED; PG8_LDA(At, 1, 0); PG8_STAGE(PG8_SA(0, 1), a2 + hstep, voffA);
            PG8_WAIT_L(8); PG8_BAR; PG8_WAIT_L(0); PG8_MMA(0, 0, At, B0); PG8_BAR; PG8_SCHED;
            PG8_LDB(B1, 1, 1); PG8_STAGE(PG8_SB(1, 0), b3, voffB);
            PG8_BAR; PG8_WAIT_L(0); PG8_MMA(0, 1, At, B1); PG8_BAR;
            PG8_LDA(At, 1, 1); PG8_STAGE(PG8_SA(1, 0), a3, voffA);
            PG8_BAR; PG8_WAIT_L(0); PG8_MMA(1, 0, At, B0); PG8_BAR; PG8_SCHED;
            PG8_STAGE(PG8_SB(1, 1), b3 + hstep, voffB);
            PG8_WAIT_V(6); PG8_BAR; PG8_MMA(1, 1, At, B1); PG8_BAR;
            }
        }
        if constexpr (ALIGN_EPI) { if (wr == 0) PG8_BAR; }
        if constexpr (!Epi::AFTER_DRAIN) { E(acc, cur, wr, wc, fr, fq); S.done(cur); }
        if (!has_next) break;
#pragma unroll
        for (int a = 0; a < 2; ++a)
#pragma unroll
            for (int b = 0; b < 2; ++b)
#pragma unroll
                for (int m = 0; m < 4; ++m)
#pragma unroll
                    for (int n = 0; n < 2; ++n) acc[a][b][m][n] = (f32x4){0.f, 0.f, 0.f, 0.f};
        cur = nxt; cA = nA; cB = nB; ++ui;
        if constexpr (ALIGN_EPI) { if (wr == 1) PG8_BAR; }
    }
    PG8_WAIT_V(0);
    if constexpr (!ALIGN_EPI) { if (wr == 0) PG8_BAR; }
    PG8_BAR;
    if constexpr (Epi::AFTER_DRAIN) { E.fused(acc, cur, wr, wc, fr, fq, lds, wid, lane); S.done(cur); }
#undef PG8_SA
#undef PG8_SB
#undef PG8_STAGE
#undef PG8_LDA
#undef PG8_LDB
#undef PG8_MMA
#undef PG8_WAIT_V
#undef PG8_WAIT_L
#undef PG8_BAR
#undef PG8_SCHED
}
}

#define LAS __attribute__((address_space(3)))
typedef unsigned short bf16_t;
typedef float f32x4 __attribute__((ext_vector_type(4)));
typedef short bf16x8 __attribute__((ext_vector_type(8)));
typedef unsigned u32x4 __attribute__((ext_vector_type(4)));
typedef unsigned u32x2 __attribute__((ext_vector_type(2)));

constexpr int NWAVES = 8, NTHR = 512;
constexpr int DM = 1024, DFF = 2816, DPROJ = 8704;
constexpr int M_PROMPT = 65536, M_ALL = 81920, GROWS = 16384, NGROUPS = 5;
constexpr int C_AQ = 0, C_AK = 1024, C_AV = 1280, C_HQ = 1536, C_HFF = 2560, C_HFB = 3584, C_HI = 4608, C_HG = 5632, C_GA = 6656, C_GH = 7680;
constexpr float LN_EPS = 1e-5f, RMS_EPS = 1e-6f;
constexpr float DN_ALPHA = 1.189207115002721f;

constexpr size_t MiB = 1u << 20;
constexpr size_t WS_W1IN = 0, WS_W1OUT = 11 * MiB, WS_WIN = 17 * MiB, WS_WOA = 34 * MiB, WS_WOH = 36 * MiB, WS_WOUT = 38 * MiB, WS_W2IN = 40 * MiB, WS_W2OUT = 51 * MiB;
constexpr size_t WS_BAR = 60 * MiB;
constexpr size_t WS_XB = 64 * MiB;
constexpr size_t WS_H = 224 * MiB;
constexpr size_t WS_PROJ = 224 * MiB;
constexpr size_t WS_ATTO = 496 * MiB;
constexpr size_t WS_HGG = 528 * MiB;
constexpr size_t WS_SLOC = 560 * MiB;
constexpr size_t WS_DLOG = 592 * MiB;
constexpr size_t WS_OF = 594 * MiB;
constexpr size_t WS_OB = 658 * MiB;
constexpr size_t WS_T1 = 722 * MiB;
constexpr size_t WS_MRG = 786 * MiB;
constexpr size_t WS_END = 818 * MiB;
constexpr int LDS_BYTES = 147456;

struct Params { const float* in[19]; float* out; unsigned char* ws; };

typedef float f32x2_t __attribute__((ext_vector_type(2)));
typedef __bf16 bf16x2_t __attribute__((ext_vector_type(2)));
__device__ __forceinline__ unsigned pk2(float lo, float hi) { const bf16x2_t v = __builtin_convertvector((f32x2_t){lo, hi}, bf16x2_t); return __builtin_bit_cast(unsigned, v); }
__device__ __forceinline__ unsigned f2bf(float f) { return pk2(f, 0.f) & 0xffffu; }
__device__ __forceinline__ float bf2f(unsigned h) { return __builtin_bit_cast(float, h << 16); }
__device__ __forceinline__ float bflo(unsigned w) { return __builtin_bit_cast(float, w << 16); }
__device__ __forceinline__ float bfhi(unsigned w) { return __builtin_bit_cast(float, w & 0xffff0000u); }
__device__ __forceinline__ float sigmoidf_(float x) { return __builtin_amdgcn_rcpf(1.0f + __expf(-x)); }
__device__ __forceinline__ float siluf_(float x) { return x * sigmoidf_(x); }
__device__ __forceinline__ float wave_sum(float v) {
#pragma unroll
    for (int o = 1; o < 64; o <<= 1) v += __shfl_xor(v, o);
    return v;
}

#define XB_TMO      128
#define XB_XCNT(j)  (256  + 64 * (j))
#define XB_XSUB(j)  (1280 + 64 * (j))
#define XB_XGEN(j)  (2304 + 64 * (j))
#define XB_TOP      3328
#define XB_TOPGEN   3392
#define XCD_BAR_WORDS 3456
#define XB_SPIN_CAP (1u << 18)

__device__ __forceinline__ unsigned xb_ld(unsigned* p)              { return __hip_atomic_load(p, __ATOMIC_RELAXED, __HIP_MEMORY_SCOPE_AGENT); }
__device__ __forceinline__ unsigned xb_add(unsigned* p, unsigned v) { return __hip_atomic_fetch_add(p, v, __ATOMIC_RELAXED, __HIP_MEMORY_SCOPE_AGENT); }
__device__ __forceinline__ unsigned xb_xcc_id() { return (unsigned)__builtin_amdgcn_s_getreg((3 << 11) | 20) & 0xFu; }
#define XB_SPIN(cond, bar) do { unsigned _sp = 0; while (cond) { __builtin_amdgcn_s_sleep(1); \
    if ((++_sp & 255u) == 0u) { if (xb_ld(&(bar)[XB_TMO])) break; if (_sp > XB_SPIN_CAP) { atomicAdd(&(bar)[XB_TMO], 1u); break; } } } } while (0)

struct XcdBarrier {
    unsigned* bar; unsigned x;
    volatile LAS unsigned* st;
};

__device__ __forceinline__ XcdBarrier xcd_barrier_post(unsigned* bar, volatile LAS unsigned* st) {
    XcdBarrier b; b.bar = bar; b.x = xb_xcc_id(); b.st = st;
    if (threadIdx.x == 0) (void)xb_add(&bar[XB_XCNT(b.x)], 1u);
    return b;
}
__device__ __forceinline__ void xcd_barrier_complete(unsigned* bar, unsigned x, unsigned& nloc, unsigned& nx) {
    const unsigned G = gridDim.x * gridDim.y * gridDim.z;
    unsigned sum, cnt, mine, sp = 0u;
    for (;;) {
        sum = 0u; cnt = 0u; mine = 0u;
#pragma unroll
        for (unsigned j = 0; j < 16; ++j) { const unsigned c = xb_ld(&bar[XB_XCNT(j)]); sum += c; cnt += (c > 0u) ? 1u : 0u; mine = (j == x) ? c : mine; }
        if (sum == G) break;
        __builtin_amdgcn_s_sleep(1);
        if ((++sp & 255u) == 0u) { if (xb_ld(&bar[XB_TMO])) break; if (sp > XB_SPIN_CAP) { atomicAdd(&bar[XB_TMO], 1u); break; } }
    }
    nloc = mine > 0u ? mine : 1u; nx = cnt > 0u ? cnt : 1u;
}

__device__ __forceinline__ void xcd_barrier(const XcdBarrier& b) {
    asm volatile("s_waitcnt vmcnt(0)" ::: "memory");
    __syncthreads();
    if (threadIdx.x == 0) {
        unsigned* bar = b.bar;
        __builtin_amdgcn_s_waitcnt(0);
        unsigned nloc = b.st[0], nx = b.st[1];
        if (nloc == 0u) { xcd_barrier_complete(bar, b.x, nloc, nx); b.st[0] = nloc; b.st[1] = nx; }
        const unsigned old = xb_add(&bar[XB_XSUB(b.x)], 1u);
        const unsigned gen = old / nloc;
        if (old + 1u == (gen + 1u) * nloc) {
            __builtin_amdgcn_fence(__ATOMIC_RELEASE, "agent");
            asm volatile("s_waitcnt vmcnt(0)" ::: "memory");
            const unsigned og = xb_add(&bar[XB_TOP], 1u);
            const unsigned tg = og / nx;
            if (og + 1u == (tg + 1u) * nx) xb_add(&bar[XB_TOPGEN], 1u);
            else XB_SPIN(xb_ld(&bar[XB_TOPGEN]) == tg, bar);
            __builtin_amdgcn_fence(__ATOMIC_ACQUIRE, "agent");
            xb_add(&bar[XB_XGEN(b.x)], 1u);
            asm volatile("s_waitcnt vmcnt(0)" ::: "memory");
        } else {
            XB_SPIN(xb_ld(&bar[XB_XGEN(b.x)]) == gen, bar);
            __builtin_amdgcn_fence(__ATOMIC_ACQUIRE, "agent");
            asm volatile("s_waitcnt vmcnt(0)" ::: "memory");
        }
    }
    __syncthreads();
}

namespace pg8 {
struct EpiSwiGLU {
    static constexpr bool PERM = true, AFTER_DRAIN = false;
    bf16_t* H; int ldh;
    __device__ __forceinline__ void operator()(const f32x4 (&acc)[2][2][4][2], const Unit& u, int wr, int wc, int fr, int fq) const {
        const int row0 = u.pm * BM + wr * 64 + fr, col0 = u.pn * 128 + wc * 32 + 8 * fq;
#pragma unroll
        for (int ai = 0; ai < 2; ++ai)
#pragma unroll
            for (int m = 0; m < 4; ++m) {
                bf16_t* rowp = H + (size_t)(row0 + ai * HALF + m * 16) * ldh + col0;
                float v[8];
#pragma unroll
                for (int n = 0; n < 2; ++n)
#pragma unroll
                    for (int e = 0; e < 4; ++e) { const float g = acc[ai][0][m][n][e], up = acc[ai][1][m][n][e]; v[n * 4 + e] = g * __builtin_amdgcn_rcpf(1.0f + __expf(-g)) * up; }
                u32x4 w; w.x = cvt_pk_bf16(v[0], v[1]); w.y = cvt_pk_bf16(v[2], v[3]); w.z = cvt_pk_bf16(v[4], v[5]); w.w = cvt_pk_bf16(v[6], v[7]);
                *(u32x4*)rowp = w;
            }
    }
};
struct EpiResid {
    static constexpr bool PERM = false, AFTER_DRAIN = false;
    const float* base0; const float* base1; int split; float* out; float alpha, scale;
    __device__ __forceinline__ void operator()(const f32x4 (&acc)[2][2][4][2], const Unit& u, int wr, int wc, int fr, int fq) const {
        const int row0 = u.pm * BM + wr * 64 + fr, col0 = u.pn * BM + wc * 32 + 4 * fq;
#pragma unroll
        for (int ai = 0; ai < 2; ++ai)
#pragma unroll
            for (int m = 0; m < 4; ++m) {
                const int r = row0 + ai * HALF + m * 16;
                const float* b = (r < split) ? base0 + (size_t)r * 1024 : base1 + (size_t)(r - split) * 1024;
                float* o = out + (size_t)r * 1024;
#pragma unroll
                for (int bj = 0; bj < 2; ++bj)
#pragma unroll
                    for (int n = 0; n < 2; ++n) { const int c = col0 + bj * HALF + n * 16; const f32x4 bs = *(const f32x4*)(b + c);
                        *(f32x4*)(o + c) = bs * alpha + acc[ai][bj][m][n] * scale; }
            }
    }
};
template <bool SECOND> struct EpiGate {
    static constexpr bool PERM = true, AFTER_DRAIN = false;
    const bf16_t* gate; int ldg; float* t1; bf16_t* mrg;
    __device__ __forceinline__ void operator()(const f32x4 (&acc)[2][2][4][2], const Unit& u, int wr, int wc, int fr, int fq) const {
        const int row0 = u.pm * BM + wr * 64 + fr, col0 = u.pn * BM + wc * 32 + 8 * fq;
#pragma unroll
        for (int ai = 0; ai < 2; ++ai)
#pragma unroll
            for (int m = 0; m < 4; ++m) {
                const int r = row0 + ai * HALF + m * 16;
#pragma unroll
                for (int bj = 0; bj < 2; ++bj) {
                    const int c = col0 + bj * HALF;
                    const u32x4 gw = *(const u32x4*)(gate + (size_t)r * ldg + c);
                    float g[8] = {bflo(gw.x), bfhi(gw.x), bflo(gw.y), bfhi(gw.y), bflo(gw.z), bfhi(gw.z), bflo(gw.w), bfhi(gw.w)};
                    float v[8];
#pragma unroll
                    for (int n = 0; n < 2; ++n)
#pragma unroll
                        for (int e = 0; e < 4; ++e) v[n * 4 + e] = __builtin_amdgcn_rcpf(1.0f + __expf(-g[n * 4 + e])) * acc[ai][bj][m][n][e];
                    float* tp = t1 + (size_t)r * 1024 + c;
                    if (!SECOND) { *(f32x4*)tp = (f32x4){v[0], v[1], v[2], v[3]}; *(f32x4*)(tp + 4) = (f32x4){v[4], v[5], v[6], v[7]}; }
                    else { const f32x4 a = *(const f32x4*)tp, b = *(const f32x4*)(tp + 4);
                        u32x4 w; w.x = cvt_pk_bf16(v[0] + a[0], v[1] + a[1]); w.y = cvt_pk_bf16(v[2] + a[2], v[3] + a[3]); w.z = cvt_pk_bf16(v[4] + b[0], v[5] + b[1]); w.w = cvt_pk_bf16(v[6] + b[2], v[7] + b[3]);
                        *(u32x4*)(mrg + (size_t)r * 1024 + c) = w; }
                }
            }
    }
};
}

__device__ __forceinline__ void p0_transpose_item(const float* W, int K, int N, bf16_t* WT, bool swiglu, LAS float* scr, int item, int lane) {
    const int nblk = N / 32, kb = item / nblk, nb = item % nblk, k0 = 64 * kb, n0 = 32 * nb;
    int r0 = n0;
    if (swiglu) { const int isup = n0 >= DFF ? 1 : 0, j = n0 - isup * DFF; r0 = 256 * (j >> 7) + 128 * isup + (j & 127); }
#pragma unroll 8
    for (int i = 0; i < 32; ++i) { const int kk = 2 * i + (lane >> 5); scr[kk * 33 + (lane & 31)] = W[(size_t)(k0 + kk) * N + n0 + (lane & 31)]; }
    asm volatile("s_waitcnt lgkmcnt(0)" ::: "memory");
    const int c = lane & 7;
#pragma unroll
    for (int j = 0; j < 4; ++j) { const int n = (lane >> 3) + 8 * j; const LAS float* s = scr + (8 * c) * 33 + n;
        u32x4 o; o.x = pk2(s[0 * 33], s[1 * 33]); o.y = pk2(s[2 * 33], s[3 * 33]); o.z = pk2(s[4 * 33], s[5 * 33]); o.w = pk2(s[6 * 33], s[7 * 33]);
        *(u32x4*)(WT + (size_t)(r0 + n) * K + k0 + 8 * c) = o; }
    asm volatile("s_waitcnt lgkmcnt(0)" ::: "memory");
}

__device__ __forceinline__ void prologue_phase(const Params& p, LAS unsigned char* lds, int gw, int NGW, int wid, int lane) {
    LAS float* scr = (LAS float*)(lds + wid * 16384);
    unsigned char* ws = p.ws;
    constexpr int I_FIN = (DM / 64) * (2 * DFF / 32), I_FOUT = (DFF / 64) * (DM / 32), I_WIN = (DM / 64) * (DPROJ / 32), I_SQ = (DM / 64) * (DM / 32);
    constexpr int NITEMS = 2 * I_FIN + 2 * I_FOUT + I_WIN + 3 * I_SQ;
    for (int it = gw; it < NITEMS; it += NGW) {
        int r = it;
        if (r < I_FIN) { p0_transpose_item(p.in[2], DM, 2 * DFF, (bf16_t*)(ws + WS_W1IN), true, scr, r, lane); continue; } r -= I_FIN;
        if (r < I_FOUT) { p0_transpose_item(p.in[3], DFF, DM, (bf16_t*)(ws + WS_W1OUT), false, scr, r, lane); continue; } r -= I_FOUT;
        if (r < I_WIN) { p0_transpose_item(p.in[6], DM, DPROJ, (bf16_t*)(ws + WS_WIN), false, scr, r, lane); continue; } r -= I_WIN;
        if (r < I_SQ) { p0_transpose_item(p.in[10], DM, DM, (bf16_t*)(ws + WS_WOA), false, scr, r, lane); continue; } r -= I_SQ;
        if (r < I_SQ) { p0_transpose_item(p.in[11], DM, DM, (bf16_t*)(ws + WS_WOH), false, scr, r, lane); continue; } r -= I_SQ;
        if (r < I_SQ) { p0_transpose_item(p.in[12], DM, DM, (bf16_t*)(ws + WS_WOUT), false, scr, r, lane); continue; } r -= I_SQ;
        if (r < I_FIN) { p0_transpose_item(p.in[15], DM, 2 * DFF, (bf16_t*)(ws + WS_W2IN), true, scr, r, lane); continue; } r -= I_FIN;
        p0_transpose_item(p.in[16], DFF, DM, (bf16_t*)(ws + WS_W2OUT), false, scr, r, lane);
    }
    bf16_t* xb = (bf16_t*)(ws + WS_XB);
    for (int m = gw; m < M_ALL; m += NGW) {
        const float* xr = (m < M_PROMPT) ? p.in[0] + (size_t)m * DM : p.in[1] + (size_t)(m - M_PROMPT) * DM;
        const f32x4* x4 = (const f32x4*)xr + lane;
        u32x2* o8 = (u32x2*)(xb + (size_t)m * DM) + lane;
#pragma unroll
        for (int j = 0; j < 4; ++j) { const f32x4 v = x4[64 * j]; u32x2 w; w.x = pk2(v.x, v.y); w.y = pk2(v.z, v.w); o8[64 * j] = w; }
    }
}

__device__ __forceinline__ void ln_phase(const float* z, float* xo, bf16_t* xbo, const float* g, const float* b, int gw, int NGW, int lane) {
    f32x4 gv[4], bv[4];
#pragma unroll
    for (int j = 0; j < 4; ++j) { gv[j] = ((const f32x4*)g)[lane + 64 * j]; bv[j] = ((const f32x4*)b)[lane + 64 * j]; }
    for (int m = gw; m < M_ALL; m += NGW) {
        const f32x4* xr = (const f32x4*)(z + (size_t)m * DM) + lane;
        f32x4 v[4]; float s = 0.f;
#pragma unroll
        for (int j = 0; j < 4; ++j) { v[j] = xr[64 * j]; s += (v[j].x + v[j].y) + (v[j].z + v[j].w); }
        const float mean = wave_sum(s) * (1.f / DM); float s2 = 0.f;
#pragma unroll
        for (int j = 0; j < 4; ++j) { v[j] = v[j] - mean; s2 += (v[j].x * v[j].x + v[j].y * v[j].y) + (v[j].z * v[j].z + v[j].w * v[j].w); }
        const float rstd = 1.f / sqrtf(wave_sum(s2) * (1.f / DM) + LN_EPS);
        f32x4* o4 = (f32x4*)(xo + (size_t)m * DM) + lane;
#pragma unroll
        for (int j = 0; j < 4; ++j) { const f32x4 y = v[j] * rstd * gv[j] + bv[j]; o4[64 * j] = y;
            if (xbo) { u32x2 w; w.x = pk2(y.x, y.y); w.y = pk2(y.z, y.w); ((u32x2*)(xbo + (size_t)m * DM) + lane)[64 * j] = w; } }
    }
}

__device__ __forceinline__ void fast_sincos(float x, float& s, float& c) {
    const float k = rintf(x * 0.15915494309189535f);
    float r = fmaf(-k, 6.28125f, x); r = fmaf(-k, 1.9353071795864769e-3f, r);
    s = __sinf(r); c = __cosf(r);
}
__device__ __forceinline__ void rope8(u32x4& own, const u32x4& oth, float pos, bool second) {
    const float inv[8] = {1.0f, 0.19392274474868576f, 0.03760603093086393f, 0.007292664737217109f, 0.001414213562373095f, 0.0002742481756762073f, 5.318295896944988e-05f, 1.031338537721246e-05f};
    unsigned ow[4] = {own.x, own.y, own.z, own.w}, tw[4] = {oth.x, oth.y, oth.z, oth.w}, rw[4];
#pragma unroll
    for (int j = 0; j < 4; ++j) {
        float s0, c0, s1, c1; fast_sincos(pos * inv[2 * j], s0, c0); fast_sincos(pos * inv[2 * j + 1], s1, c1);
        if (second) { s0 = -s0; s1 = -s1; }
        const float a0 = bflo(ow[j]) * c0 - bflo(tw[j]) * s0, a1 = bfhi(ow[j]) * c1 - bfhi(tw[j]) * s1;
        rw[j] = pk2(a0, a1);
    }
    own.x = rw[0]; own.y = rw[1]; own.z = rw[2]; own.w = rw[3];
}

__device__ __forceinline__ void attn_phase(LAS unsigned char* lds, const bf16_t* proj, bf16_t* atto, const float* sink, int L, int bid, int G, int tid) {
    const int wid = tid >> 6, lane = tid & 63, fr = lane & 15, fq = lane >> 4;
    constexpr int KS = 144, VS = 784;
    LAS unsigned char* Kl = lds;
    LAS unsigned char* Vl = lds + 384 * KS;
    for (int item = bid; item < 512; item += G) {
        const int qb = item >> 2, kvh = item & 3;
        const int tb = qb * 128, pos0 = tb % L, n = pos0 >> 7, nb = L >> 7;
        const bool vlo = n > 0, vhi = (n + 1) < nb;
        __syncthreads();
        for (int idx = tid; idx < 1536; idx += NTHR) {
            const int r = idx >> 2, qd = idx & 3, blk = r >> 7;
            const bool valid = (blk == 1) || (blk == 0 ? vlo : vhi);
            u32x4 c0 = (u32x4){0u, 0u, 0u, 0u}, c1 = c0;
            if (valid) {
                const bf16_t* src = proj + (size_t)(tb - 128 + r) * DPROJ + C_AK + kvh * 64 + qd * 16;
                c0 = *(const u32x4*)src; c1 = *(const u32x4*)(src + 8);
                if (qd == 0) { const float pos = (float)(pos0 - 128 + r); const u32x4 x1 = c0, x2 = c1; rope8(c0, x2, pos, false); rope8(c1, x1, pos, true); }
            }
            *(LAS u32x4*)(Kl + r * KS + qd * 32) = c0; *(LAS u32x4*)(Kl + r * KS + qd * 32 + 16) = c1;
        }
        for (int idx = tid; idx < 3072; idx += NTHR) {
            const int r = idx % 384, ch = idx / 384, blk = r >> 7;
            const bool valid = (blk == 1) || (blk == 0 ? vlo : vhi);
            u32x4 v = (u32x4){0u, 0u, 0u, 0u};
            if (valid) v = *(const u32x4*)(proj + (size_t)(tb - 128 + r) * DPROJ + C_AV + kvh * 64 + ch * 8);
            const unsigned vw[4] = {v.x, v.y, v.z, v.w};
#pragma unroll
            for (int e = 0; e < 4; ++e) {
                *(LAS unsigned short*)(Vl + (ch * 8 + 2 * e) * VS + r * 2) = (unsigned short)(vw[e] & 0xffffu);
                *(LAS unsigned short*)(Vl + (ch * 8 + 2 * e + 1) * VS + r * 2) = (unsigned short)(vw[e] >> 16);
            }
        }
        __syncthreads();
        const int hq = kvh * 4 + (wid >> 1);
        const float snk = sink[hq];
        for (int rt = 0; rt < 4; ++rt) {
            const int qi0 = (wid & 1) * 64 + rt * 16;
            const int qrow = tb + qi0 + fr;
            const bf16_t* qsrc = proj + (size_t)qrow * DPROJ + C_AQ + hq * 64 + 8 * fq;
            u32x4 q0 = *(const u32x4*)qsrc, q1 = *(const u32x4*)(qsrc + 32);
            {
                u32x4 oth; oth.x = __shfl_xor(q0.x, 16); oth.y = __shfl_xor(q0.y, 16); oth.z = __shfl_xor(q0.z, 16); oth.w = __shfl_xor(q0.w, 16);
                if (fq < 2) rope8(q0, oth, (float)(pos0 + qi0 + fr), fq == 1);
            }
            const bf16x8 qv0 = __builtin_bit_cast(bf16x8, q0), qv1 = __builtin_bit_cast(bf16x8, q1);
            const int qi = qi0 + fr;
            int c_lo = qi0 >> 5, c_hi = (qi0 + 271) >> 5; if (c_hi > 11) c_hi = 11;
            if (!vlo && c_lo < 4) c_lo = 4;
            if (!vhi && c_hi > 7) c_hi = 7;
            float mrow = snk, lsum = 0.f;
            f32x4 o[4];
#pragma unroll
            for (int dt = 0; dt < 4; ++dt) o[dt] = (f32x4){0.f, 0.f, 0.f, 0.f};
#pragma unroll 1
            for (int c = c_lo; c <= c_hi; ++c) {
                f32x4 s2[2];
#pragma unroll
                for (int h = 0; h < 2; ++h) {
                    const int krow = 32 * c + 16 * h + fr;
                    const bf16x8 a0 = *(const LAS bf16x8*)(Kl + krow * KS + fq * 16), a1 = *(const LAS bf16x8*)(Kl + krow * KS + fq * 16 + 64);
                    f32x4 acc = (f32x4){0.f, 0.f, 0.f, 0.f};
                    acc = __builtin_amdgcn_mfma_f32_16x16x32_bf16(a0, qv0, acc, 0, 0, 0);
                    acc = __builtin_amdgcn_mfma_f32_16x16x32_bf16(a1, qv1, acc, 0, 0, 0);
                    s2[h] = acc;
                }
                const bool bv = (c < 4) ? vlo : ((c >= 8) ? vhi : true);
                float mx = -1e30f;
#pragma unroll
                for (int h = 0; h < 2; ++h)
#pragma unroll
                    for (int r = 0; r < 4; ++r) {
                        const int d = 32 * c + 16 * h + 4 * fq + r - 128 - qi;
                        const bool ok = bv && (d <= 128) && (d >= -128);
                        const float v = ok ? s2[h][r] * 0.125f : -1e30f;
                        s2[h][r] = v; mx = fmaxf(mx, v);
                    }
                mx = fmaxf(mx, __shfl_xor(mx, 16)); mx = fmaxf(mx, __shfl_xor(mx, 32));
                const float mnew = fmaxf(mrow, mx), alpha = __expf(mrow - mnew);
                mrow = mnew;
                float ps = 0.f;
#pragma unroll
                for (int h = 0; h < 2; ++h)
#pragma unroll
                    for (int r = 0; r < 4; ++r) { const float e = __expf(s2[h][r] - mnew); s2[h][r] = e; ps += e; }
                lsum = lsum * alpha + ps;
                u32x4 pw; pw.x = pk2(s2[0][0], s2[0][1]); pw.y = pk2(s2[0][2], s2[0][3]); pw.z = pk2(s2[1][0], s2[1][1]); pw.w = pk2(s2[1][2], s2[1][3]);
                const bf16x8 pf = __builtin_bit_cast(bf16x8, pw);
#pragma unroll
                for (int dt = 0; dt < 4; ++dt) {
                    const u32x2 v0 = *(const LAS u32x2*)(Vl + (16 * dt + fr) * VS + (32 * c + 4 * fq) * 2), v1 = *(const LAS u32x2*)(Vl + (16 * dt + fr) * VS + (32 * c + 16 + 4 * fq) * 2);
                    u32x4 vw; vw.x = v0.x; vw.y = v0.y; vw.z = v1.x; vw.w = v1.y;
                    o[dt] = o[dt] * alpha;
                    o[dt] = __builtin_amdgcn_mfma_f32_16x16x32_bf16(__builtin_bit_cast(bf16x8, vw), pf, o[dt], 0, 0, 0);
                }
            }
            lsum += __shfl_xor(lsum, 16); lsum += __shfl_xor(lsum, 32);
            const float invd = 1.0f / (lsum + __expf(snk - mrow));
            bf16_t* dst = atto + (size_t)qrow * DM + hq * 64 + 4 * fq;
#pragma unroll
            for (int dt = 0; dt < 4; ++dt) { u32x2 w; w.x = pk2(o[dt][0] * invd, o[dt][1] * invd); w.y = pk2(o[dt][2] * invd, o[dt][3] * invd); *(u32x2*)(dst + 16 * dt) = w; }
        }
    }
}

typedef short s16x4 __attribute__((ext_vector_type(4)));
__device__ __forceinline__ bf16x8 tr_pair(LAS unsigned char* a0, LAS unsigned char* a1) {
    const s16x4 x = __builtin_amdgcn_ds_read_tr16_b64_v4i16((LAS s16x4*)a0), y = __builtin_amdgcn_ds_read_tr16_b64_v4i16((LAS s16x4*)a1);
    return (bf16x8){x[0], x[1], x[2], x[3], y[0], y[1], y[2], y[3]};
}
#define LBAR() do { asm volatile("s_waitcnt lgkmcnt(0)" ::: "memory"); __builtin_amdgcn_s_barrier(); asm volatile("" ::: "memory"); } while (0)
template <bool OUT>
__device__ __forceinline__ void hgrn_phase(LAS unsigned char* lds, const bf16_t* proj, const float* lbraw, float* sloc, float* dlog, float* of, float* ob, int bid, int G, int tid) {
    const int wid = tid >> 6, lane = tid & 63, fr = lane & 15, fq = lane >> 4;
    constexpr int RS = 272, TB = 64 * RS, SS = 272;
    LAS unsigned char* T0 = lds;
    LAS unsigned char* T1 = lds + TB;
    LAS unsigned char* T2 = lds + 2 * TB;
    LAS unsigned char* T3 = lds + 3 * TB;
    LAS unsigned char* T4 = lds + 4 * TB;
    LAS unsigned char* ST = lds + 5 * TB;
    LAS float* BL = (LAS float*)(lds + 5 * TB + 128 * SS);
    const int laneoff = (fr >> 2) * RS + (fr & 3) * 8;
    const int o8 = tid & 15, i0 = tid >> 4;
    for (int item = bid; item < 512; item += G) {
        const int seg = item >> 4, head = (item >> 1) & 7, dir = item & 1;
        float omlb8[8];
#pragma unroll
        for (int e = 0; e < 8; ++e) { const int chn = dir * 2048 + head * 128 + 8 * o8 + e; omlb8[e] = 1.0f - 1.0f / (1.0f + expf(lbraw[chn + 1024] - lbraw[chn])); }
        f32x4 S[8];
        LBAR();
        if (OUT) {
            const float* sp = sloc + (size_t)item * 16384 + (16 * wid + fr) * 128 + 4 * fq;
#pragma unroll
            for (int kt = 0; kt < 8; ++kt) { S[kt] = *(const f32x4*)(sp + 16 * kt);
                u32x2 w; w.x = pk2(S[kt][0], S[kt][1]); w.y = pk2(S[kt][2], S[kt][3]); *(LAS u32x2*)(ST + (16 * wid + fr) * SS + (16 * kt + 4 * fq) * 2) = w; }
        } else {
#pragma unroll
            for (int kt = 0; kt < 8; ++kt) S[kt] = (f32x4){0.f, 0.f, 0.f, 0.f};
        }
        f32x4 dacc = (f32x4){0.f, 0.f, 0.f, 0.f};
        const int fcol = (dir ? C_HFB : C_HFF);
        u32x4 pf[2][3];
#define HG_LOAD(cidx) do { const int c0n_ = seg * 512 + (dir ? 7 - (cidx) : (cidx)) * 64; _Pragma("unroll") for (int k_ = 0; k_ < 2; ++k_) { const int i_ = i0 + 32 * k_, t_ = dir ? c0n_ + 63 - i_ : c0n_ + i_; \
            const bf16_t* rp_ = proj + (size_t)t_ * DPROJ + head * 128 + 8 * o8; pf[k_][0] = *(const u32x4*)(rp_ + fcol); if (OUT) pf[k_][1] = *(const u32x4*)(rp_ + C_HQ); pf[k_][2] = *(const u32x4*)(rp_ + C_HI); } } while (0)
        HG_LOAD(0);
        for (int c = 0; c < 8; ++c) {
            const int c0 = seg * 512 + (dir ? 7 - c : c) * 64;
            LBAR();
#pragma unroll
            for (int k = 0; k < 2; ++k) {
                const int i = i0 + 32 * k;
                const unsigned fw[4] = {pf[k][0].x, pf[k][0].y, pf[k][0].z, pf[k][0].w};
                unsigned hw[4], lw[4];
                unsigned kw[4];
#pragma unroll
                for (int j = 0; j < 4; ++j) {
                    const float s0 = __builtin_amdgcn_rcpf(1.0f + __builtin_amdgcn_exp2f(bflo(fw[j]) * -1.4426950408889634f)), s1 = __builtin_amdgcn_rcpf(1.0f + __builtin_amdgcn_exp2f(bfhi(fw[j]) * -1.4426950408889634f));
                    const float k0 = fmaf(-omlb8[2 * j], s0, omlb8[2 * j]), k1 = fmaf(-omlb8[2 * j + 1], s1, omlb8[2 * j + 1]);
                    const float l0 = __builtin_amdgcn_logf(1.0f - k0), l1 = __builtin_amdgcn_logf(1.0f - k1);
                    hw[j] = pk2(l0, l1);
                    lw[j] = pk2(l0 - bflo(hw[j]), l1 - bfhi(hw[j]));
                    kw[j] = pk2(k0, k1);
                }
                const int off = i * RS + o8 * 16;
                *(LAS u32x4*)(T0 + off) = (u32x4){hw[0], hw[1], hw[2], hw[3]};
                *(LAS u32x4*)(T1 + off) = (u32x4){lw[0], lw[1], lw[2], lw[3]};
                *(LAS u32x4*)(T2 + off) = (u32x4){kw[0], kw[1], kw[2], kw[3]};
                if (OUT) *(LAS u32x4*)(T3 + off) = pf[k][1];
                *(LAS u32x4*)(T4 + off) = pf[k][2];
            }
            if (c < 7) HG_LOAD(c + 1);
            LBAR();
            {
                bf16x8 ah[2], al[2];
#pragma unroll
                for (int jc = 0; jc < 2; ++jc) {
                    const int o = (32 * jc + 8 * fq) * RS + (16 * wid) * 2 + laneoff;
                    ah[jc] = tr_pair(T0 + o, T0 + o + 4 * RS); al[jc] = tr_pair(T1 + o, T1 + o + 4 * RS);
                }
                const short one = (short)0x3F80;
                const bf16x8 ones = (bf16x8){one, one, one, one, one, one, one, one};
                f32x4 tot = (f32x4){0.f, 0.f, 0.f, 0.f};
#pragma unroll
                for (int jc = 0; jc < 2; ++jc) { tot = __builtin_amdgcn_mfma_f32_16x16x32_bf16(ah[jc], ones, tot, 0, 0, 0); tot = __builtin_amdgcn_mfma_f32_16x16x32_bf16(al[jc], ones, tot, 0, 0, 0); }
                dacc += tot;
                f32x4 etot; etot[0] = __builtin_amdgcn_exp2f(tot[0]); etot[1] = __builtin_amdgcn_exp2f(tot[1]); etot[2] = __builtin_amdgcn_exp2f(tot[2]); etot[3] = __builtin_amdgcn_exp2f(tot[3]);
                if (fr == 0) *(LAS f32x4*)(BL + 16 * wid + 4 * fq) = etot;
#pragma unroll
                for (int it = 0; it < 4; ++it) {
                    f32x4 b = (f32x4){0.f, 0.f, 0.f, 0.f};
#pragma unroll
                    for (int jc = 0; jc < 2; ++jc) {
                        if (32 * jc <= 16 * it + 15) {
                            bf16x8 tt;
#pragma unroll
                            for (int jj = 0; jj < 8; ++jj) tt[jj] = (32 * jc + 8 * fq + jj <= 16 * it + fr) ? one : (short)0;
                            b = __builtin_amdgcn_mfma_f32_16x16x32_bf16(ah[jc], tt, b, 0, 0, 0); b = __builtin_amdgcn_mfma_f32_16x16x32_bf16(al[jc], tt, b, 0, 0, 0);
                        }
                    }
                    const int off = (16 * it + fr) * RS + (16 * wid + 4 * fq) * 2;
                    const u32x2 kkw = *(const LAS u32x2*)(T2 + off);
                    const float kk[4] = {bflo(kkw.x), bfhi(kkw.x), bflo(kkw.y), bfhi(kkw.y)};
                    float ki[4], ke[4];
                    if (OUT) {
                        const u32x2 qw = *(const LAS u32x2*)(T3 + off);
                        const float q4[4] = {bflo(qw.x), bfhi(qw.x), bflo(qw.y), bfhi(qw.y)};
                        float qd[4];
#pragma unroll
                        for (int r = 0; r < 4; ++r) {
                            const float eb = __builtin_amdgcn_exp2f(b[r]), enb = __builtin_amdgcn_rcpf(eb);
                            qd[r] = q4[r] * eb * __builtin_amdgcn_rcpf(1.0f + __builtin_amdgcn_exp2f(q4[r] * -1.4426950408889634f));
                            ki[r] = kk[r] * enb; ke[r] = ki[r] * etot[r];
                        }
                        u32x2 w; w.x = pk2(qd[0], qd[1]); w.y = pk2(qd[2], qd[3]); *(LAS u32x2*)(T3 + off) = w;
                        w.x = pk2(ki[0], ki[1]); w.y = pk2(ki[2], ki[3]); *(LAS u32x2*)(T2 + off) = w;
                    } else {
#pragma unroll
                        for (int r = 0; r < 4; ++r) ke[r] = kk[r] * __builtin_amdgcn_exp2f(tot[r] - b[r]);
                    }
                    u32x2 w; w.x = pk2(ke[0], ke[1]); w.y = pk2(ke[2], ke[3]); *(LAS u32x2*)(T0 + off) = w;
                }
            }
            LBAR();
            if (OUT) {
                const int it = wid & 3, dh = wid >> 2;
                bf16x8 qf[4];
#pragma unroll
                for (int cc = 0; cc < 4; ++cc) qf[cc] = *(const LAS bf16x8*)(T3 + (16 * it + fr) * RS + (32 * cc + 8 * fq) * 2);
                f32x4 at[4];
#pragma unroll
                for (int jt = 0; jt < 4; ++jt) {
                    f32x4 a = (f32x4){0.f, 0.f, 0.f, 0.f};
#pragma unroll
                    for (int cc = 0; cc < 4; ++cc) { const bf16x8 kf = *(const LAS bf16x8*)(T2 + (16 * jt + fr) * RS + (32 * cc + 8 * fq) * 2); a = __builtin_amdgcn_mfma_f32_16x16x32_bf16(kf, qf[cc], a, 0, 0, 0); }
#pragma unroll
                    for (int r = 0; r < 4; ++r) { const int j = 16 * jt + 4 * fq + r, i = 16 * it + fr; if (j > i) a[r] = 0.f; }
                    at[jt] = a;
                }
                bf16x8 pa[2];
#pragma unroll
                for (int jc = 0; jc < 2; ++jc) { u32x4 w; w.x = pk2(at[2 * jc][0], at[2 * jc][1]); w.y = pk2(at[2 * jc][2], at[2 * jc][3]); w.z = pk2(at[2 * jc + 1][0], at[2 * jc + 1][1]); w.w = pk2(at[2 * jc + 1][2], at[2 * jc + 1][3]); pa[jc] = __builtin_bit_cast(bf16x8, w); }
                const int isc = 16 * it + fr, tok = dir ? c0 + 63 - isc : c0 + isc;
                float* dst = (dir ? ob : of) + (size_t)tok * DM + head * 128 + 4 * fq;
#pragma unroll
                for (int d4 = 0; d4 < 4; ++d4) {
                    const int dt = 4 * dh + d4;
                    f32x4 o = (f32x4){0.f, 0.f, 0.f, 0.f};
#pragma unroll
                    for (int jc = 0; jc < 2; ++jc) {
                        const int ov = (32 * jc + 4 * fq) * RS + (16 * dt) * 2 + laneoff;
                        const bf16x8 vfr = tr_pair(T4 + ov, T4 + ov + 16 * RS);
                        o = __builtin_amdgcn_mfma_f32_16x16x32_bf16(vfr, pa[jc], o, 0, 0, 0);
                    }
#pragma unroll
                    for (int cc = 0; cc < 4; ++cc) { const bf16x8 sf = *(const LAS bf16x8*)(ST + (16 * dt + fr) * SS + (32 * cc + 8 * fq) * 2); o = __builtin_amdgcn_mfma_f32_16x16x32_bf16(sf, qf[cc], o, 0, 0, 0); }
                    *(f32x4*)(dst + 16 * dt) = o;
                }
                LBAR();
            }
            bf16x8 vf[2];
#pragma unroll
            for (int tc = 0; tc < 2; ++tc) { const int ov = (32 * tc + 8 * fq) * RS + (16 * wid) * 2 + laneoff; vf[tc] = tr_pair(T4 + ov, T4 + ov + 4 * RS); }
#pragma unroll
            for (int kt = 0; kt < 8; ++kt) {
                const f32x4 bl4 = *(const LAS f32x4*)(BL + 16 * kt + 4 * fq);
                f32x4 a = S[kt];
                a = a * bl4;
#pragma unroll
                for (int tc = 0; tc < 2; ++tc) { const int ok = (32 * tc + 8 * fq) * RS + (16 * kt) * 2 + laneoff; const bf16x8 kef = tr_pair(T0 + ok, T0 + ok + 4 * RS); a = __builtin_amdgcn_mfma_f32_16x16x32_bf16(kef, vf[tc], a, 0, 0, 0); }
                S[kt] = a;
                if (OUT) { u32x2 w; w.x = pk2(a[0], a[1]); w.y = pk2(a[2], a[3]); *(LAS u32x2*)(ST + (16 * wid + fr) * SS + (16 * kt + 4 * fq) * 2) = w; }
            }
        }
#undef HG_LOAD
        if (!OUT) {
            float* sp = sloc + (size_t)item * 16384 + (16 * wid + fr) * 128 + 4 * fq;
#pragma unroll
            for (int kt = 0; kt < 8; ++kt) *(f32x4*)(sp + 16 * kt) = S[kt];
            if (fr == 0) *(f32x4*)(dlog + item * 128 + 16 * wid + 4 * fq) = dacc;
        }
    }
}

__device__ __forceinline__ void hgrn_chain_phase(float* sloc, const float* dlog, int L, int gtid, int NT) {
    const int nseg = L / 512, nseq = GROWS / L, nchain = nseq * 16;
    const int total = nchain * 4096;
    for (int idx = gtid; idx < total; idx += NT) {
        const int chain = idx >> 12, e4 = idx & 4095;
        const int sq = chain >> 4, hd = chain & 15, dir = hd & 1;
        const int dk = (e4 * 4) & 127;
        f32x4 run = (f32x4){0.f, 0.f, 0.f, 0.f};
        for (int s = 0; s < nseg; ++s) {
            const int seg = sq * nseg + (dir ? nseg - 1 - s : s);
            const int item = seg * 16 + hd;
            f32x4* sp = (f32x4*)(sloc + (size_t)item * 16384) + e4;
            const f32x4 tmp = *sp;
            const f32x4 dl = *(const f32x4*)(dlog + item * 128 + dk);
            *sp = run;
            run[0] = __builtin_amdgcn_exp2f(dl[0]) * run[0] + tmp[0]; run[1] = __builtin_amdgcn_exp2f(dl[1]) * run[1] + tmp[1]; run[2] = __builtin_amdgcn_exp2f(dl[2]) * run[2] + tmp[2]; run[3] = __builtin_amdgcn_exp2f(dl[3]) * run[3] + tmp[3];
        }
    }
}

__device__ __forceinline__ void hgrn_combine_phase(const float* of, const float* ob, const bf16_t* proj, const float* normg, bf16_t* hgg, int gw, int NGW, int lane) {
    float ng[16];
#pragma unroll
    for (int e = 0; e < 16; ++e) ng[e] = normg[(lane & 7) * 16 + e];
    for (int t = gw; t < GROWS; t += NGW) {
        const f32x4* a = (const f32x4*)(of + (size_t)t * DM + lane * 16);
        const f32x4* b = (const f32x4*)(ob + (size_t)t * DM + lane * 16);
        float o[16]; float ss = 0.f;
#pragma unroll
        for (int j = 0; j < 4; ++j) { const f32x4 x = a[j] + b[j]; o[4 * j] = x[0]; o[4 * j + 1] = x[1]; o[4 * j + 2] = x[2]; o[4 * j + 3] = x[3]; ss += (x[0] * x[0] + x[1] * x[1]) + (x[2] * x[2] + x[3] * x[3]); }
        ss += __shfl_xor(ss, 1); ss += __shfl_xor(ss, 2); ss += __shfl_xor(ss, 4);
        const float r = 1.0f / sqrtf(ss * (1.0f / 128.0f) + RMS_EPS);
        const u32x4* gp = (const u32x4*)(proj + (size_t)t * DPROJ + C_HG + lane * 16);
        const u32x4 g0 = gp[0], g1 = gp[1];
        const unsigned gwd[8] = {g0.x, g0.y, g0.z, g0.w, g1.x, g1.y, g1.z, g1.w};
        unsigned w[8];
#pragma unroll
        for (int j = 0; j < 8; ++j) { const float v0 = o[2 * j] * r * ng[2 * j] * siluf_(bflo(gwd[j])), v1 = o[2 * j + 1] * r * ng[2 * j + 1] * siluf_(bfhi(gwd[j])); w[j] = pk2(v0, v1); }
        u32x4* dp = (u32x4*)(hgg + (size_t)t * DM + lane * 16);
        dp[0] = (u32x4){w[0], w[1], w[2], w[3]}; dp[1] = (u32x4){w[4], w[5], w[6], w[7]};
    }
}

#ifndef REP_GEMM
#define REP_GEMM 1
#endif
#ifndef REP_ATTN
#define REP_ATTN 1
#endif
#ifndef REP_HG
#define REP_HG 1
#endif
#ifndef REP_HG1
#define REP_HG1 REP_HG
#endif
#ifndef REP_HG3
#define REP_HG3 REP_HG
#endif
#ifndef REP_HGC
#define REP_HGC REP_HG
#endif
#ifndef REP_LN
#define REP_LN 1
#endif
#ifndef REP_PRO
#define REP_PRO 1
#endif
#define REPEAT(n) for (int rep_ = 0; rep_ < (n); ++rep_)
__global__ void __launch_bounds__(NTHR, 2) fwd_megakernel(Params p_unused) {
    typedef const volatile Params __attribute__((address_space(4))) * KParamsPtr;
    KParamsPtr pp = (KParamsPtr)__builtin_amdgcn_kernarg_segment_ptr();
#define PIN(i) ((const float*)pp->in[i])
#define WSP(off) ((unsigned char*)pp->ws + (off))
    extern __shared__ __attribute__((aligned(16))) unsigned char lds_raw[];
    cg::grid_group grid = cg::this_grid();
    LAS unsigned char* lds = (LAS unsigned char*)lds_raw;
    const int G = gridDim.x, NGW = G * NWAVES;
    volatile LAS unsigned* bar_st = (volatile LAS unsigned*)(lds + 131072 + 512);
    if (threadIdx.x < 4) bar_st[threadIdx.x] = 0u;
    __syncthreads();
    { XcdBarrier b0 = xcd_barrier_post((unsigned*)WSP(WS_BAR), bar_st); (void)b0; }
#define GSYNC() do { XcdBarrier b_; b_.bar = (unsigned*)WSP(WS_BAR); b_.x = xb_xcc_id(); b_.st = bar_st; xcd_barrier(b_); } while (0)
#define PHASE_VARS int tid = threadIdx.x, bid = blockIdx.x; asm volatile("" : "+v"(tid)); asm volatile("" : "+s"(bid)); const int lane = tid & 63, wid = __builtin_amdgcn_readfirstlane(tid >> 6), gw = bid * NWAVES + wid; (void)lane; (void)gw;
#define xb ((bf16_t*)WSP(WS_XB))
#define hb ((bf16_t*)WSP(WS_H))
#define xres ((float*)pp->out)
#define proj ((bf16_t*)WSP(WS_PROJ))
#define atto ((bf16_t*)WSP(WS_ATTO))
#define hgg ((bf16_t*)WSP(WS_HGG))
#define sloc ((float*)WSP(WS_SLOC))
#define dlog ((float*)WSP(WS_DLOG))
#define of ((float*)WSP(WS_OF))
#define ob ((float*)WSP(WS_OB))
#define t1 ((float*)WSP(WS_T1))
#define mrg ((bf16_t*)WSP(WS_MRG))
#define WPTR(off) ((const bf16_t*)WSP(off))

    REPEAT(REP_PRO) { PHASE_VARS Params p; for (int i = 0; i < 19; ++i) p.in[i] = PIN(i); p.out = (float*)pp->out; p.ws = WSP(0); prologue_phase(p, lds, gw, NGW, wid, lane); }
    grid.sync();

    REPEAT(REP_GEMM) {
        PHASE_VARS pg8::Gemm g{xb, WPTR(WS_W1IN), M_ALL, 2 * DFF, DM}; pg8::StaticOrder S; S.init(M_ALL, 2 * DFF, G, bid);
        pg8::EpiSwiGLU E{hb, DFF};
        pg8::gemm_phase<pg8::EpiSwiGLU, pg8::StaticOrder, true, true>(lds, g, S, E, tid);
    }
    GSYNC();
    REPEAT(REP_GEMM) {
        PHASE_VARS pg8::Gemm g{hb, WPTR(WS_W1OUT), M_ALL, DM, DFF}; pg8::StaticOrder S; S.init(M_ALL, DM, G, bid);
        pg8::EpiResid E{PIN(0), PIN(1), M_PROMPT, xres, DN_ALPHA, 0.5f};
        pg8::gemm_phase<pg8::EpiResid, pg8::StaticOrder, true, true>(lds, g, S, E, tid);
    }
    GSYNC();
    { PHASE_VARS ln_phase(xres, xres, xb, PIN(4), PIN(5), gw, NGW, lane); }
    GSYNC();

    for (int grp = 0; grp < NGROUPS; ++grp) {
        const int L = (grp < 4) ? 4096 : 16384;
        const size_t r0 = (size_t)grp * GROWS;
        REPEAT(REP_GEMM) {
            PHASE_VARS pg8::Gemm g{xb + r0 * DM, WPTR(WS_WIN), GROWS, DPROJ, DM}; pg8::StaticOrder S; S.init(GROWS, DPROJ, G, bid);
            pg8::EpiBf16<0> E{proj, DPROJ, nullptr, 0, 0, 1.f};
            pg8::gemm_phase<pg8::EpiBf16<0>, pg8::StaticOrder, true, true>(lds, g, S, E, tid);
        }
        GSYNC();
        REPEAT(REP_ATTN) { PHASE_VARS attn_phase(lds, proj, atto, PIN(7), L, bid, G, tid); }
        REPEAT(REP_HG1) { PHASE_VARS hgrn_phase<false>(lds, proj, PIN(8), sloc, dlog, of, ob, bid, G, tid); }
        GSYNC();
        { PHASE_VARS hgrn_chain_phase(sloc, dlog, L, bid * NTHR + tid, G * NTHR); }
        GSYNC();
        REPEAT(REP_HG3) { PHASE_VARS hgrn_phase<true>(lds, proj, PIN(8), sloc, dlog, of, ob, bid, G, tid); }
        GSYNC();
        REPEAT(REP_HGC) { PHASE_VARS hgrn_combine_phase(of, ob, proj, PIN(9), hgg, gw, NGW, lane); }
        GSYNC();
        REPEAT(REP_GEMM) {
            PHASE_VARS pg8::Gemm g{atto, WPTR(WS_WOA), GROWS, DM, DM}; pg8::StaticOrder S; S.init(GROWS, DM, G, bid);
            pg8::EpiGate<false> E{proj + C_GA, DPROJ, t1, mrg};
            pg8::gemm_phase<pg8::EpiGate<false>, pg8::StaticOrder, true, true>(lds, g, S, E, tid);
        }
        GSYNC();
        REPEAT(REP_GEMM) {
            PHASE_VARS pg8::Gemm g{hgg, WPTR(WS_WOH), GROWS, DM, DM}; pg8::StaticOrder S; S.init(GROWS, DM, G, bid);
            pg8::EpiGate<true> E{proj + C_GH, DPROJ, t1, mrg};
            pg8::gemm_phase<pg8::EpiGate<true>, pg8::StaticOrder, true, true>(lds, g, S, E, tid);
        }
        GSYNC();
        {
            PHASE_VARS pg8::Gemm g{mrg, WPTR(WS_WOUT), GROWS, DM, DM}; pg8::StaticOrder S; S.init(GROWS, DM, G, bid);
            pg8::EpiResid E{xres + r0 * DM, xres + r0 * DM, 1 << 30, xres + r0 * DM, DN_ALPHA, 1.0f};
            pg8::gemm_phase<pg8::EpiResid, pg8::StaticOrder, true, true>(lds, g, S, E, tid);
        }
        GSYNC();
    }
    { PHASE_VARS ln_phase(xres, xres, xb, PIN(13), PIN(14), gw, NGW, lane); }
    GSYNC();

    REPEAT(REP_GEMM) {
        PHASE_VARS pg8::Gemm g{xb, WPTR(WS_W2IN), M_ALL, 2 * DFF, DM}; pg8::StaticOrder S; S.init(M_ALL, 2 * DFF, G, bid);
        pg8::EpiSwiGLU E{hb, DFF};
        pg8::gemm_phase<pg8::EpiSwiGLU, pg8::StaticOrder, true, true>(lds, g, S, E, tid);
    }
    GSYNC();
    {
        PHASE_VARS pg8::Gemm g{hb, WPTR(WS_W2OUT), M_ALL, DM, DFF}; pg8::StaticOrder S; S.init(M_ALL, DM, G, bid);
        pg8::EpiResid E{xres, xres, 1 << 30, xres, DN_ALPHA, 0.5f};
        pg8::gemm_phase<pg8::EpiResid, pg8::StaticOrder, true, true>(lds, g, S, E, tid);
    }
    GSYNC();
    { PHASE_VARS ln_phase(xres, xres, nullptr, PIN(17), PIN(18), gw, NGW, lane); }
}

extern "C" void kernel_launch(void* const* d_in, const int* in_sizes, int n_in, void* d_out, int out_size, void* d_ws, size_t ws_size, hipStream_t stream) {
    static int grid = 0;
    if (grid == 0) {
        if (n_in != 19 || out_size != M_ALL * DM || ws_size < WS_END) { fprintf(stderr, "kernel_launch: unexpected shapes (n_in %d out %d ws %zu)\n", n_in, out_size, ws_size); grid = -1; return; }
        int dev = 0, cus = 0, per_cu = 0;
        hipGetDevice(&dev);
        hipDeviceGetAttribute(&cus, hipDeviceAttributeMultiprocessorCount, dev);
        if (hipFuncSetAttribute((const void*)fwd_megakernel, hipFuncAttributeMaxDynamicSharedMemorySize, LDS_BYTES) != hipSuccess) { fprintf(stderr, "kernel_launch: hipFuncSetAttribute failed\n"); grid = -1; return; }
        if (hipOccupancyMaxActiveBlocksPerMultiprocessor(&per_cu, (const void*)fwd_megakernel, NTHR, LDS_BYTES) != hipSuccess || per_cu < 1) { fprintf(stderr, "kernel_launch: occupancy query gives %d\n", per_cu); per_cu = 1; }
        (void)hipGetLastError();
        grid = cus * 1;
        fprintf(stderr, "kernel_launch: grid %d (cus %d, per_cu %d)\n", grid, cus, per_cu);
    }
    if (grid < 0) return;
    Params p{};
    for (int i = 0; i < 19; ++i) p.in[i] = (const float*)d_in[i];
    p.out = (float*)d_out; p.ws = (unsigned char*)d_ws;
    if (hipMemsetAsync((char*)d_ws + WS_BAR, 0, XCD_BAR_WORDS * 4, stream) != hipSuccess) { fprintf(stderr, "kernel_launch: memset failed\n"); return; }
    void* args[] = {&p};
    hipError_t e = hipLaunchCooperativeKernel((const void*)fwd_megakernel, dim3(grid), dim3(NTHR), args, LDS_BYTES, stream);
    if (e != hipSuccess) fprintf(stderr, "cooperative launch failed: %s (grid %d)\n", hipGetErrorString(e), grid);
}
```
